# Optimizing an MI355X kernel written in HIP

```python
import jax, jax.numpy as jnp
from jax import lax
import numpy as np

D_MODEL = 1024
BATCH = 8
SEQ = 4096
DEPTH = 4

N_EVEN = (DEPTH + 1) // 2
N_ODD = DEPTH // 2
NORM_EPS = 1e-6
D_FF = 2816

CONV_WIDTH = D_MODEL // 2
CONV_GROUPS = 8
CONV_TAPS = 3
RWKV_WIDTH = D_MODEL - CONV_WIDTH
RWKV_HEAD = 64
RWKV_HEADS = RWKV_WIDTH // RWKV_HEAD
DECAY_RANK = 32
ICLR_RANK = 32
GATE_RANK = 96
RWKV_GN_EPS = 64e-5
RWKV_SHIFT_COLS = 3 * RWKV_WIDTH + DECAY_RANK + ICLR_RANK + GATE_RANK
EVEN_IN = 3 * CONV_WIDTH + RWKV_SHIFT_COLS
_RWKV_SPLITS = (RWKV_WIDTH, 2 * RWKV_WIDTH, 3 * RWKV_WIDTH,
                3 * RWKV_WIDTH + DECAY_RANK, 3 * RWKV_WIDTH + DECAY_RANK + ICLR_RANK)

MLA_HEADS = 8
Q_RANK = 384
KV_RANK = 256
NOPE_DIM = 128
ROPE_DIM = 64
V_DIM = 128
QK_DIM = NOPE_DIM + ROPE_DIM
ODD_IN = Q_RANK + KV_RANK + ROPE_DIM
ROPE_THETA = 10000.0
Q_BLOCK = 128
ATTN_SCALE = QK_DIM ** -0.5

kernel_name = "hybrid_conv_rwkv7_mla_macaron"


def _rmsnorm(x, gain, eps=NORM_EPS):
    xf = x.astype(jnp.float32)
    y = xf * lax.rsqrt(jnp.mean(xf * xf, axis=-1, keepdims=True) + eps)
    return (y * gain.astype(jnp.float32)).astype(x.dtype)


def _swiglu(h, w_gate, w_up, w_down):
    return (jax.nn.silu(h @ w_gate) * (h @ w_up)) @ w_down


def _shift(u):
    return jnp.pad(u, ((0, 0), (1, 0), (0, 0)))[:, :-1]


def _short_conv(u, w):
    T = u.shape[1]
    up = jnp.pad(u, ((0, 0), (CONV_TAPS - 1, 0), (0, 0)))
    return sum(up[:, j:j + T] * w[j] for j in range(CONV_TAPS))


def _rwkv7_scan(r, decay, k, v, a_vec, b_vec):
    B, T, H, N = r.shape

    def step(S, inp):
        r_t, w_t, k_t, v_t, a_t, b_t = inp
        Sa = jnp.einsum('bhvk,bhk->bhv', S, a_t)
        S = S * w_t[:, :, None, :] + Sa[..., None] * b_t[:, :, None, :] + v_t[..., None] * k_t[:, :, None, :]
        return S, jnp.einsum('bhvk,bhk->bhv', S, r_t)

    xs = tuple(jnp.moveaxis(t, 1, 0) for t in (r, decay, k, v, a_vec, b_vec))
    S0 = jnp.zeros((B, H, N, N), jnp.float32)
    _, y = lax.scan(step, S0, xs)
    return jnp.moveaxis(y, 0, 1)


def _conv_rwkv_mixer(h, w_in, conv_w, mu_shift, w0, w_up, a0, a_up, g_up,
                     k_k, k_a, r_k, ln_w, ln_b, w_out):
    B, T, _ = h.shape
    f32 = jnp.float32
    p = h @ w_in
    p_conv, p_rwkv = p[..., :3 * CONV_WIDTH], p[..., 3 * CONV_WIDTH:]
    gate_b, gate_c, h_in = jnp.split(p_conv, 3, axis=-1)
    y_conv = gate_b * _short_conv(gate_c * h_in, conv_w)
    p_rwkv = p_rwkv + (_shift(p_rwkv) - p_rwkv) * mu_shift
    r, k, v, dw, da, dg = jnp.split(p_rwkv, _RWKV_SPLITS, axis=-1)
    log_w = -jax.nn.softplus(-(w0 + jnp.tanh(dw) @ w_up).astype(f32)) - 0.5
    decay = jnp.exp(-jnp.exp(log_w))
    a = jax.nn.sigmoid((a0 + da @ a_up).astype(f32))
    g = jax.nn.sigmoid(dg) @ g_up

    def heads(t):
        return t.astype(f32).reshape(B, T, RWKV_HEADS, RWKV_HEAD)

    r_h, v_h, a_h, decay_h = heads(r), heads(v), heads(a), heads(decay)
    kk = heads(k * k_k)
    kk = kk * lax.rsqrt(jnp.maximum(jnp.sum(kk * kk, axis=-1, keepdims=True), 1e-24))
    k_h = heads(k) * (1.0 + (a_h - 1.0) * k_a.astype(f32).reshape(RWKV_HEADS, RWKV_HEAD))
    y = _rwkv7_scan(r_h, decay_h, k_h, v_h, -kk, kk * a_h)
    mu = jnp.mean(y, axis=-1, keepdims=True)
    var = jnp.mean(jnp.square(y - mu), axis=-1, keepdims=True)
    y = (y - mu) * lax.rsqrt(var + RWKV_GN_EPS) * ln_w.astype(f32).reshape(RWKV_HEADS, RWKV_HEAD) \
        + ln_b.astype(f32).reshape(RWKV_HEADS, RWKV_HEAD)
    y = y + jnp.sum(r_h * k_h * r_k.astype(f32), axis=-1, keepdims=True) * v_h
    y_rwkv = y.reshape(B, T, RWKV_WIDTH).astype(h.dtype) * g
    return jnp.concatenate([y_conv, y_rwkv], axis=-1) @ w_out


def _rope(t, cos, sin):
    t1, t2 = t[..., :ROPE_DIM // 2], t[..., ROPE_DIM // 2:]
    return jnp.concatenate([t1 * cos - t2 * sin, t2 * cos + t1 * sin], axis=-1)


def _causal_attention(q, k, v):
    B, T, H, Dk = q.shape
    nb = T // Q_BLOCK
    qb = q.reshape(B, nb, Q_BLOCK, H, Dk).transpose(1, 0, 3, 2, 4)
    kpos = jnp.arange(T)

    def one_block(args):
        qi, i = args
        s = jnp.einsum('bhqd,bkhd->bhqk', qi, k, preferred_element_type=jnp.float32) * ATTN_SCALE
        qpos = i * Q_BLOCK + jnp.arange(Q_BLOCK)
        s = jnp.where(kpos[None, :] <= qpos[:, None], s, jnp.finfo(jnp.float32).min)
        p = jax.nn.softmax(s, axis=-1)
        return jnp.einsum('bhqk,bkhd->bqhd', p.astype(v.dtype), v)

    out = lax.map(one_block, (qb, jnp.arange(nb)))
    return out.transpose(1, 0, 2, 3, 4).reshape(B, T, H, v.shape[-1])


def _mla_mixer(h, cos, sin, w_in, q_a_norm, kv_a_norm, w_q_up, w_kv_up, q_norm, k_norm, w_out):
    B, T, _ = h.shape
    p = h @ w_in
    c_q, c_kv, k_pe = jnp.split(p, (Q_RANK, Q_RANK + KV_RANK), axis=-1)
    q = (_rmsnorm(c_q, q_a_norm) @ w_q_up).reshape(B, T, MLA_HEADS, QK_DIM)
    kv = (_rmsnorm(c_kv, kv_a_norm) @ w_kv_up).reshape(B, T, MLA_HEADS, NOPE_DIM + V_DIM)
    k_nope, v = kv[..., :NOPE_DIM], kv[..., NOPE_DIM:]
    k = jnp.concatenate([k_nope, jnp.broadcast_to(k_pe[:, :, None, :], (B, T, MLA_HEADS, ROPE_DIM))], axis=-1)
    q = _rmsnorm(q, q_norm)
    k = _rmsnorm(k, k_norm)
    q = jnp.concatenate([q[..., :NOPE_DIM], _rope(q[..., NOPE_DIM:], cos, sin)], axis=-1)
    k = jnp.concatenate([k[..., :NOPE_DIM], _rope(k[..., NOPE_DIM:], cos, sin)], axis=-1)
    o = _causal_attention(q, k, v)
    return o.reshape(B, T, MLA_HEADS * V_DIM) @ w_out


def setup_inputs(seed: int = 0) -> dict:
    key = jax.random.key(seed)
    ks = iter(jax.random.split(key, 32))
    f32 = jnp.float32

    def nrm(shape, fan_in):
        return jax.random.normal(next(ks), shape, f32) * fan_in ** -0.5

    def gain(shape):
        return 1.0 + 0.02 * jax.random.normal(next(ks), shape, f32)

    def unif(shape, lo, hi):
        return jax.random.uniform(next(ks), shape, f32, lo, hi)

    x = jax.random.normal(next(ks), (BATCH, SEQ, D_MODEL), f32)
    offset = jax.random.randint(next(ks), (BATCH, 1), 0, 1024, jnp.int32)
    positions = (offset + jnp.arange(SEQ, dtype=jnp.int32)[None, :]).astype(jnp.int32)
    return {
        "x": x,
        "positions": positions,
        "norm_gains": gain((DEPTH, 3, D_MODEL)),
        "ffn_w_gate": nrm((DEPTH, 2, D_MODEL, D_FF), D_MODEL),
        "ffn_w_up": nrm((DEPTH, 2, D_MODEL, D_FF), D_MODEL),
        "ffn_w_down": nrm((DEPTH, 2, D_FF, D_MODEL), D_FF),
        "even_w_in": nrm((N_EVEN, D_MODEL, EVEN_IN), D_MODEL),
        "even_conv_w": nrm((N_EVEN, CONV_TAPS, CONV_WIDTH), CONV_TAPS),
        "even_mu_shift": unif((N_EVEN, RWKV_SHIFT_COLS), 0.0, 1.0),
        "rwkv_w0": unif((N_EVEN, RWKV_WIDTH), -6.0, 0.0),
        "rwkv_w_up": nrm((N_EVEN, DECAY_RANK, RWKV_WIDTH), DECAY_RANK),
        "rwkv_a0": 0.1 * jax.random.normal(next(ks), (N_EVEN, RWKV_WIDTH), f32),
        "rwkv_a_up": nrm((N_EVEN, ICLR_RANK, RWKV_WIDTH), ICLR_RANK),
        "rwkv_g_up": nrm((N_EVEN, GATE_RANK, RWKV_WIDTH), GATE_RANK),
        "rwkv_k_k": 0.85 + 0.05 * jax.random.normal(next(ks), (N_EVEN, RWKV_WIDTH), f32),
        "rwkv_k_a": gain((N_EVEN, RWKV_WIDTH)),
        "rwkv_r_k": 0.1 * jax.random.normal(next(ks), (N_EVEN, RWKV_HEADS, RWKV_HEAD), f32),
        "rwkv_ln_w": gain((N_EVEN, RWKV_WIDTH)),
        "rwkv_ln_b": 0.02 * jax.random.normal(next(ks), (N_EVEN, RWKV_WIDTH), f32),
        "even_w_out": nrm((N_EVEN, CONV_WIDTH + RWKV_WIDTH, D_MODEL), CONV_WIDTH + RWKV_WIDTH),
        "odd_w_in": nrm((N_ODD, D_MODEL, ODD_IN), D_MODEL),
        "mla_q_a_norm": gain((N_ODD, Q_RANK)),
        "mla_kv_a_norm": gain((N_ODD, KV_RANK)),
        "mla_w_q_up": nrm((N_ODD, Q_RANK, MLA_HEADS * QK_DIM), Q_RANK),
        "mla_w_kv_up": nrm((N_ODD, KV_RANK, MLA_HEADS * (NOPE_DIM + V_DIM)), KV_RANK),
        "mla_q_norm": gain((N_ODD, QK_DIM)),
        "mla_k_norm": gain((N_ODD, QK_DIM)),
        "odd_w_out": nrm((N_ODD, MLA_HEADS * V_DIM, D_MODEL), MLA_HEADS * V_DIM),
    }


def reference(x, positions, norm_gains, ffn_w_gate, ffn_w_up, ffn_w_down,
              even_w_in, even_conv_w, even_mu_shift, rwkv_w0, rwkv_w_up, rwkv_a0, rwkv_a_up,
              rwkv_g_up, rwkv_k_k, rwkv_k_a, rwkv_r_k, rwkv_ln_w, rwkv_ln_b, even_w_out,
              odd_w_in, mla_q_a_norm, mla_kv_a_norm, mla_w_q_up, mla_w_kv_up,
              mla_q_norm, mla_k_norm, odd_w_out):
    inv_freq = ROPE_THETA ** (-jnp.arange(0, ROPE_DIM, 2, dtype=jnp.float32) / ROPE_DIM)
    ang = positions.astype(jnp.float32)[..., None] * inv_freq
    cos = jnp.cos(ang)[:, :, None, :].astype(x.dtype)
    sin = jnp.sin(ang)[:, :, None, :].astype(x.dtype)

    for layer in range(DEPTH):
        g = norm_gains[layer]
        x = x + 0.5 * _swiglu(_rmsnorm(x, g[0]), ffn_w_gate[layer, 0], ffn_w_up[layer, 0], ffn_w_down[layer, 0])
        h = _rmsnorm(x, g[1])
        if layer % 2 == 0:
            i = layer // 2
            mix = _conv_rwkv_mixer(h, even_w_in[i], even_conv_w[i], even_mu_shift[i], rwkv_w0[i],
                                   rwkv_w_up[i], rwkv_a0[i], rwkv_a_up[i], rwkv_g_up[i], rwkv_k_k[i],
                                   rwkv_k_a[i], rwkv_r_k[i], rwkv_ln_w[i], rwkv_ln_b[i], even_w_out[i])
        else:
            j = layer // 2
            mix = _mla_mixer(h, cos, sin, odd_w_in[j], mla_q_a_norm[j], mla_kv_a_norm[j], mla_w_q_up[j],
                             mla_w_kv_up[j], mla_q_norm[j], mla_k_norm[j], odd_w_out[j])
        x = x + mix.astype(x.dtype)
        x = x + 0.5 * _swiglu(_rmsnorm(x, g[2]), ffn_w_gate[layer, 1], ffn_w_up[layer, 1], ffn_w_down[layer, 1])
    return x
```

```cpp
#include <hip/hip_runtime.h>
#include <hip/hip_cooperative_groups.h>
#include <cstdio>
#include <cstdint>
namespace cg = cooperative_groups;
namespace pg8 {
#define PG8_LAS __attribute__((address_space(3)))
typedef unsigned short bf16_t;
typedef short bf16x8 __attribute__((ext_vector_type(8)));
typedef float f32x4 __attribute__((ext_vector_type(4)));
typedef unsigned u32x4 __attribute__((ext_vector_type(4)));
constexpr int BM = 256, BK = 64, HALF = 128, HTB = HALF * BK * 2  , STAGE_BYTES = 8 * HTB, NXCD = 8, WGM = 8;

__host__ __device__ __forceinline__ int lds_byte(int r, int c) { const int st = (r >> 4) * 2 + (c >> 5), rr = r & 15, cc = c & 31, ob = rr * 64 + cc * 2; return st * 1024 + (ob ^ (((ob >> 9) & 1) << 5)); }
__host__ __device__ __forceinline__ void stage_rc(int b, int& R, int& C) { const int st = b / 1024, sb = b % 1024, swz = sb ^ (((sb >> 9) & 1) << 5); R = (st >> 1) * 16 + swz / 64; C = (st & 1) * 32 + (swz % 64) / 2; }
__host__ __device__ __forceinline__ int perm32(int rho) { const int n = rho >> 4, i = rho & 15; return 8 * (i >> 2) + 4 * n + (i & 3); }

struct Unit { int pm, pn; };
struct Gemm { const bf16_t* A; const bf16_t* Bt; int M, N, K; };

struct StaticOrder {
    int nM, nN, nwg, G, c;
    __host__ __device__ void init(int M, int N, int G_, int c_) { nM = M / BM; nN = N / BM; nwg = nM * nN; G = G_; c = c_; }
    __host__ __device__ bool next(int i, Unit& u) const {
        const long L = (long)i * G + c; if (L >= nwg) return false;
        int wgid = (int)L; { const int q = nwg / NXCD, r = nwg % NXCD, xcd = wgid % NXCD, off = wgid / NXCD; wgid = (xcd < r ? xcd * (q + 1) : r * (q + 1) + (xcd - r) * q) + off; }
        const int nig = WGM * nN, gid = wgid / nig, fm = gid * WGM, gsz = (nM - fm) < WGM ? (nM - fm) : WGM;
        u.pm = fm + ((wgid % nig) % gsz); u.pn = (wgid % nig) / gsz; return true;
    }
    __device__ __forceinline__ void a_ready(const Unit&) const {}
    __device__ __forceinline__ void done(const Unit&) const {}
};

__device__ __forceinline__ unsigned cvt_pk_bf16(float lo, float hi) { unsigned r; asm volatile("v_cvt_pk_bf16_f32 %0, %1, %2" : "=v"(r) : "v"(lo), "v"(hi)); return r; }
typedef float f32x2 __attribute__((ext_vector_type(2)));
template <class Epi, class Sched, bool ALIGN_EPI = false, bool SP2 = false>
__device__ __forceinline__ void gemm_phase(PG8_LAS unsigned char* lds, const Gemm g, const Sched& S, const Epi& E) {
    int tid_ = threadIdx.x; asm volatile("" : "+v"(tid_));
    const int tid = tid_, wid = __builtin_amdgcn_readfirstlane(tid >> 6), lane = tid & 63, wr = wid >> 2, wc = wid & 3, fr = lane & 15, fq = lane >> 4;
    const int K = g.K, nt = K / BK;
    unsigned voffA[2], voffB[2];
#pragma unroll
    for (int i = 0; i < 2; ++i) { int R, C; stage_rc(tid * 16 + i * 8192, R, C); const int Rb0 = Epi::PERM ? ((R & ~31) + perm32(R & 31)) : R; const int Rb = Epi::VTOK ? ((Rb0 & ~31) + 16 * ((Rb0 >> 2) & 1) + 4 * ((Rb0 >> 3) & 3) + (Rb0 & 3)) : Rb0;
        voffA[i] = (unsigned)(R * K + C) * 2u; voffB[i] = (unsigned)(Rb * K + C) * 2u; }
    const size_t kstep = (size_t)(BK * 2);
    const size_t hstep = (size_t)HALF * K * 2;
    const size_t tstep = 2 * hstep;
    const unsigned ldsw = (unsigned)wid * 1024u;
    const int aoff = lds_byte(wr * 64 + fr, fq * 8), boff = lds_byte(wc * 32 + fr, fq * 8);
#define PG8_SA(b, h) (((b) * 2 + (h)) * HTB)
#define PG8_SB(b, h) ((4 + (b) * 2 + (h)) * HTB)
#define PG8_STAGE(bufoff, gbase, voff) do { _Pragma("unroll") for (int _i = 0; _i < 2; ++_i) \
        __builtin_amdgcn_global_load_lds((const unsigned*)((const char*)(gbase) + (voff)[_i]), (PG8_LAS unsigned*)(lds + (bufoff) + ldsw + _i * 8192), 16, 0, 0); } while (0)
#define PG8_LDA(dst, b, h) do { _Pragma("unroll") for (int m = 0; m < 4; ++m) _Pragma("unroll") for (int k = 0; k < 2; ++k) dst[m][k] = *(const PG8_LAS bf16x8*)(lds + PG8_SA(b, h) + aoff + m * 2048 + k * 1024); } while (0)
#define PG8_LDB(dst, b, h) do { _Pragma("unroll") for (int n = 0; n < 2; ++n) _Pragma("unroll") for (int k = 0; k < 2; ++k) dst[n][k] = *(const PG8_LAS bf16x8*)(lds + PG8_SB(b, h) + boff + n * 2048 + k * 1024); } while (0)
#define PG8_MMA(ai, bj, At, Bt) do { __builtin_amdgcn_s_setprio(1); _Pragma("unroll") for (int m = 0; m < 4; ++m) _Pragma("unroll") for (int n = 0; n < 2; ++n) _Pragma("unroll") for (int k = 0; k < 2; ++k) \
        acc[ai][bj][m][n] = __builtin_amdgcn_mfma_f32_16x16x32_bf16(Bt[n][k], At[m][k], acc[ai][bj][m][n], 0, 0, 0); __builtin_amdgcn_s_setprio(0); } while (0)
#define PG8_WAIT_V(n) asm volatile("s_waitcnt vmcnt(" #n ")" ::: "memory")
#define PG8_WAIT_L(n) asm volatile("s_waitcnt lgkmcnt(" #n ")" ::: "memory")
#define PG8_BAR __builtin_amdgcn_s_barrier()
#define PG8_SCHED __builtin_amdgcn_sched_barrier(0)
    Unit cur, nxt; int ui = 0;
    if (!S.next(0, cur)) return;
    f32x4 acc[2][2][4][2];
#pragma unroll
    for (int a = 0; a < 2; ++a)
#pragma unroll
        for (int b = 0; b < 2; ++b)
#pragma unroll
            for (int m = 0; m < 4; ++m)
#pragma unroll
                for (int n = 0; n < 2; ++n) acc[a][b][m][n] = (f32x4){0.f, 0.f, 0.f, 0.f};
    bf16x8 At[4][2], B0[2][2], B1[2][2];
    const char* cA = (const char*)g.A + (size_t)cur.pm * tstep; const char* cB = (const char*)g.Bt + (size_t)cur.pn * tstep;
    S.a_ready(cur);
    if constexpr (SP2) {
        PG8_STAGE(PG8_SB(0, 0), cB, voffB); PG8_STAGE(PG8_SB(0, 1), cB + hstep, voffB); PG8_STAGE(PG8_SA(0, 0), cA, voffA); PG8_STAGE(PG8_SA(0, 1), cA + hstep, voffA);
        if (wr == 1) PG8_BAR;
        PG8_WAIT_V(2); PG8_BAR;
        PG8_STAGE(PG8_SB(1, 0), cB + kstep, voffB); PG8_STAGE(PG8_SA(1, 0), cA + kstep, voffA); PG8_STAGE(PG8_SB(1, 1), cB + hstep + kstep, voffB);
        PG8_WAIT_V(6); PG8_BAR;
    } else {
        PG8_STAGE(PG8_SB(0, 0), cB, voffB); PG8_STAGE(PG8_SA(0, 0), cA, voffA); PG8_STAGE(PG8_SB(0, 1), cB + hstep, voffB); PG8_STAGE(PG8_SA(0, 1), cA + hstep, voffA);
        if (wr == 1) PG8_BAR;
        PG8_WAIT_V(4); PG8_BAR;
        PG8_STAGE(PG8_SB(1, 0), cB + kstep, voffB); PG8_STAGE(PG8_SA(1, 0), cA + kstep, voffA); PG8_STAGE(PG8_SB(1, 1), cB + hstep + kstep, voffB);
        PG8_WAIT_V(6); PG8_BAR;
    }
    for (;;) {
        const bool has_next = S.next(ui + 1, nxt);
        const char* nA = has_next ? (const char*)g.A + (size_t)nxt.pm * tstep : cA; const char* nB = has_next ? (const char*)g.Bt + (size_t)nxt.pn * tstep : cB;
        for (int t = 0; t < nt; t += 2) {
            const bool last = (t == nt - 2);
            const char* a1 = cA + (size_t)(t + 1) * kstep;
            const char* a2 = last ? nA : cA + (size_t)(t + 2) * kstep; const char* b2 = last ? nB : cB + (size_t)(t + 2) * kstep;
            const char* a3 = a2 + kstep; const char* b3 = b2 + kstep;
            if (last && has_next) S.a_ready(nxt);
            if constexpr (SP2) {
            PG8_LDB(B0, 0, 0); PG8_LDB(B1, 0, 1); PG8_SCHED; PG8_LDA(At, 0, 0); PG8_STAGE(PG8_SA(1, 1), a1 + hstep, voffA);
            PG8_WAIT_V(8); PG8_WAIT_L(0); PG8_BAR; PG8_MMA(0, 0, At, B0); PG8_MMA(0, 1, At, B1); PG8_BAR; PG8_SCHED;
            PG8_LDA(At, 0, 1); PG8_STAGE(PG8_SB(0, 0), b2, voffB); PG8_STAGE(PG8_SB(0, 1), b2 + hstep, voffB); PG8_STAGE(PG8_SA(0, 0), a2, voffA);
            PG8_WAIT_V(8); PG8_WAIT_L(0); PG8_BAR; PG8_MMA(1, 0, At, B0); PG8_MMA(1, 1, At, B1); PG8_BAR; PG8_SCHED;
            PG8_LDB(B0, 1, 0); PG8_LDB(B1, 1, 1); PG8_SCHED; PG8_LDA(At, 1, 0); PG8_STAGE(PG8_SA(0, 1), a2 + hstep, voffA);
            PG8_WAIT_V(8); PG8_WAIT_L(0); PG8_BAR; PG8_MMA(0, 0, At, B0); PG8_MMA(0, 1, At, B1); PG8_BAR; PG8_SCHED;
            PG8_LDA(At, 1, 1); PG8_STAGE(PG8_SB(1, 0), b3, voffB); PG8_STAGE(PG8_SB(1, 1), b3 + hstep, voffB); PG8_STAGE(PG8_SA(1, 0), a3, voffA);
            PG8_WAIT_V(8); PG8_WAIT_L(0); PG8_BAR; PG8_MMA(1, 0, At, B0); PG8_MMA(1, 1, At, B1); PG8_BAR; PG8_SCHED;
            } else {
            PG8_LDB(B0, 0, 0); PG8_SCHED; PG8_LDA(At, 0, 0); PG8_STAGE(PG8_SA(1, 1), a1 + hstep, voffA);
            PG8_WAIT_L(8); PG8_BAR; PG8_WAIT_L(0); PG8_MMA(0, 0, At, B0); PG8_BAR; PG8_SCHED;
            PG8_LDB(B1, 0, 1); PG8_STAGE(PG8_SB(0, 0), b2, voffB);
            PG8_BAR; PG8_WAIT_L(0); PG8_MMA(0, 1, At, B1); PG8_BAR;
            PG8_LDA(At, 0, 1); PG8_STAGE(PG8_SA(0, 0), a2, voffA);
            PG8_BAR; PG8_WAIT_L(0); PG8_MMA(1, 0, At, B0); PG8_BAR; PG8_SCHED;
            PG8_STAGE(PG8_SB(0, 1), b2 + hstep, voffB);
            PG8_WAIT_V(6); PG8_BAR; PG8_MMA(1, 1, At, B1); PG8_BAR;
            PG8_LDB(B0, 1, 0); PG8_SCHED; PG8_LDA(At, 1, 0); PG8_STAGE(PG8_SA(0, 1), a2 + hstep, voffA);
            PG8_WAIT_L(8); PG8_BAR; PG8_WAIT_L(0); PG8_MMA(0, 0, At, B0); PG8_BAR; PG8_SCHED;
            PG8_LDB(B1, 1, 1); PG8_STAGE(PG8_SB(1, 0), b3, voffB);
            PG8_BAR; PG8_WAIT_L(0); PG8_MMA(0, 1, At, B1); PG8_BAR;
            PG8_LDA(At, 1, 1); PG8_STAGE(PG8_SA(1, 0), a3, voffA);
            PG8_BAR; PG8_WAIT_L(0); PG8_MMA(1, 0, At, B0); PG8_BAR; PG8_SCHED;
            PG8_STAGE(PG8_SB(1, 1), b3 + hstep, voffB);
            PG8_WAIT_V(6); PG8_BAR; PG8_MMA(1, 1, At, B1); PG8_BAR;
            }
        }
        if constexpr (ALIGN_EPI) { if (wr == 0) PG8_BAR; }
        if constexpr (!Epi::AFTER_DRAIN) { E(acc, cur, wr, wc, fr, fq); S.done(cur); }
        if (!has_next) break;
#pragma unroll
        for (int a = 0; a < 2; ++a)
#pragma unroll
            for (int b = 0; b < 2; ++b)
#pragma unroll
                for (int m = 0; m < 4; ++m)
#pragma unroll
                    for (int n = 0; n < 2; ++n) acc[a][b][m][n] = (f32x4){0.f, 0.f, 0.f, 0.f};
        cur = nxt; cA = nA; cB = nB; ++ui;
        if constexpr (ALIGN_EPI) { if (wr == 1) PG8_BAR; }
    }
    PG8_WAIT_V(0);
    if constexpr (!ALIGN_EPI) { if (wr == 0) PG8_BAR; }
    PG8_BAR;
    if constexpr (Epi::AFTER_DRAIN) { E.fused(acc, cur, wr, wc, fr, fq, lds, wid, lane); S.done(cur); }
#undef PG8_SA
#undef PG8_SB
#undef PG8_STAGE
#undef PG8_LDA
#undef PG8_LDB
#undef PG8_MMA
#undef PG8_WAIT_V
#undef PG8_WAIT_L
#undef PG8_BAR
#undef PG8_SCHED
}
}

constexpr int DM = 1024, NB = 8, SEQ = 4096, DEPTH = 4, MTOK = NB * SEQ;
constexpr int DFF = 2816;
constexpr int EVEN_IN = 3232, RW_COLS = 1696, PCONV_LD = 1536, PRW_LD = 1792;
constexpr int ODD_IN = 704, PODD_LD = 768, QRANK = 384, KVRANK = 256;
constexpr int NH = 8, QKD = 192, VD = 128;
constexpr float NORM_EPS = 1e-6f, GN_EPS = 64e-5f;
constexpr int NWAVES = 8, NTHR = 512;

typedef unsigned short bf16;
typedef unsigned u32x4 __attribute__((ext_vector_type(4)));
typedef unsigned u32x2 __attribute__((ext_vector_type(2)));
typedef float f32x4 __attribute__((ext_vector_type(4)));
typedef float f32x2 __attribute__((ext_vector_type(2)));
typedef short bf16x8 __attribute__((ext_vector_type(8)));
#define LAS __attribute__((address_space(3)))

constexpr size_t MiB = 1u << 20;
constexpr size_t WS_WGU0 = 0, WS_WD0 = WS_WGU0 + (size_t)2 * DFF * DM * 2, WS_WGU1 = WS_WD0 + (size_t)DM * DFF * 2, WS_WD1 = WS_WGU1 + (size_t)2 * DFF * DM * 2;
constexpr size_t WS_WMIX = 33 * MiB;
static_assert(WS_WD1 + (size_t)DM * DFF * 2 <= WS_WMIX, "ffn weights");
constexpr size_t WS_WIN = WS_WMIX;
constexpr size_t WS_WOUT = WS_WMIX + 7 * MiB;
constexpr size_t WS_WQ = WS_WMIX + 9 * MiB;
constexpr size_t WS_WK = WS_WMIX + 11 * MiB;
constexpr size_t WS_WV = WS_WMIX + 12 * MiB;
constexpr size_t WS_CTL = 47 * MiB, CTL_BYTES = 16384;
constexpr size_t WS_H = 48 * MiB;
constexpr size_t WS_R = 112 * MiB;
constexpr size_t WS_ACT = WS_R;
constexpr size_t WS_PRW = WS_R;
constexpr size_t WS_PCONV = WS_R + 112 * MiB;
constexpr size_t WS_OPS = WS_R + 112 * MiB;
constexpr size_t WS_GBUF = WS_R + 304 * MiB;
constexpr size_t WS_SCAL = WS_R + 336 * MiB;
constexpr size_t WS_YRAW = WS_R;
constexpr size_t WS_PODD = WS_R;
constexpr size_t WS_CQN = WS_R + 48 * MiB;
constexpr size_t WS_CKVN = WS_R + 72 * MiB;
constexpr size_t WS_KF = WS_R;
constexpr size_t WS_QB = WS_R + 96 * MiB;
constexpr size_t WS_KNOPE = WS_R + 192 * MiB;
constexpr size_t WS_VT = WS_R + 256 * MiB;
constexpr size_t WS_KPE = WS_R + 320 * MiB;
constexpr size_t WS_END = WS_R + 340 * MiB;

constexpr int LDS_MISC = 131072 + 320;
constexpr int LDS_BYTES = 147456;

__device__ __forceinline__ float bf2f(bf16 b) { return __uint_as_float((unsigned)b << 16); }
__device__ __forceinline__ float bflo(unsigned w) { return __uint_as_float(w << 16); }
__device__ __forceinline__ float bfhi(unsigned w) { return __uint_as_float(w & 0xffff0000u); }
__device__ __forceinline__ unsigned pk2(float lo, float hi) { return pg8::cvt_pk_bf16(lo, hi); }
__device__ __forceinline__ bf16 f2bf(float f) { return (bf16)(pk2(f, 0.f) & 0xffffu); }
__device__ __forceinline__ float shfl_xor_l(float v, int lane, int mask) { return __int_as_float(__builtin_amdgcn_ds_bpermute((lane ^ mask) << 2, __float_as_int(v))); }
__device__ __forceinline__ void unpack8(const u32x4 w, float (&f)[8]) { f[0] = bflo(w.x); f[1] = bfhi(w.x); f[2] = bflo(w.y); f[3] = bfhi(w.y); f[4] = bflo(w.z); f[5] = bfhi(w.z); f[6] = bflo(w.w); f[7] = bfhi(w.w); }
__device__ __forceinline__ u32x4 pack8(const float (&f)[8]) { u32x4 w; w.x = pk2(f[0], f[1]); w.y = pk2(f[2], f[3]); w.z = pk2(f[4], f[5]); w.w = pk2(f[6], f[7]); return w; }
__device__ __forceinline__ int bidx() { int b = blockIdx.x; asm volatile("" : "+s"(b)); return b; }
__device__ __forceinline__ int gdimx() { int g = gridDim.x; asm volatile("" : "+s"(g)); return g; }
__device__ __forceinline__ float sigmoidf_(float x) { return 1.f / (1.f + __expf(-x)); }
template <int CTRL> __device__ __forceinline__ float dpp_f(float x) { return __int_as_float(__builtin_amdgcn_update_dpp(0, __float_as_int(x), CTRL, 0xF, 0xF, false)); }
__device__ __forceinline__ float row16_sum(float x) {
    x += dpp_f<0x128>(x); x += dpp_f<0x124>(x); x += dpp_f<0x122>(x); x += dpp_f<0x121>(x); return x;
}
__device__ __forceinline__ float wave_sum(float v) {
    v = row16_sum(v);
    const float a = __int_as_float(__builtin_amdgcn_readlane(__float_as_int(v), 0)), b = __int_as_float(__builtin_amdgcn_readlane(__float_as_int(v), 16));
    const float c = __int_as_float(__builtin_amdgcn_readlane(__float_as_int(v), 32)), d = __int_as_float(__builtin_amdgcn_readlane(__float_as_int(v), 48));
    return (a + b) + (c + d);
}

struct EpiStore {
    static constexpr bool PERM = true, AFTER_DRAIN = false, VTOK = false;
    bf16* O0; int ldc0; int ntile0; bf16* O1; int ldc1;
    __device__ __forceinline__ void operator()(const pg8::f32x4 (&acc)[2][2][4][2], const pg8::Unit& u, int wr, int wc, int fr, int fq) const {
        const int row0 = u.pm * 256 + wr * 64 + fr;
        bf16* base; int ldc, colt;
        if (u.pn < ntile0) { base = O0; ldc = ldc0; colt = u.pn * 256; } else { base = O1; ldc = ldc1; colt = (u.pn - ntile0) * 256; }
        const int col0 = colt + wc * 32 + 8 * fq;
#pragma unroll
        for (int ai = 0; ai < 2; ++ai)
#pragma unroll
            for (int m = 0; m < 4; ++m) {
                bf16* rowp = base + (size_t)(row0 + ai * 128 + m * 16) * ldc + col0;
#pragma unroll
                for (int bj = 0; bj < 2; ++bj) {
                    const pg8::f32x4 v0 = acc[ai][bj][m][0], v1 = acc[ai][bj][m][1];
                    u32x4 w; w.x = pk2(v0[0], v0[1]); w.y = pk2(v0[2], v0[3]); w.z = pk2(v1[0], v1[1]); w.w = pk2(v1[2], v1[3]);
                    *(u32x4*)(rowp + bj * 128) = w;
                }
            }
    }
};
struct EpiStoreV : EpiStore { static constexpr bool VTOK = true; };
struct EpiSwiGLU {
    static constexpr bool PERM = true, AFTER_DRAIN = false, VTOK = false;
    bf16* O; int ldc;
    __device__ __forceinline__ void operator()(const pg8::f32x4 (&acc)[2][2][4][2], const pg8::Unit& u, int wr, int wc, int fr, int fq) const {
        const int row0 = u.pm * 256 + wr * 64 + fr;
        const int col0 = u.pn * 128 + wc * 32 + 8 * fq;
#pragma unroll
        for (int ai = 0; ai < 2; ++ai)
#pragma unroll
            for (int m = 0; m < 4; ++m) {
                bf16* rowp = O + (size_t)(row0 + ai * 128 + m * 16) * ldc + col0;
                float r[8];
#pragma unroll
                for (int n = 0; n < 2; ++n)
#pragma unroll
                    for (int j = 0; j < 4; ++j) {
                        const float g = acc[ai][0][m][n][j], up = acc[ai][1][m][n][j];
                        const float s = g * __builtin_amdgcn_rcpf(1.f + __builtin_amdgcn_exp2f(-1.4426950408889634f * g));
                        r[n * 4 + j] = s * up;
                    }
                u32x4 w; w.x = pk2(r[0], r[1]); w.y = pk2(r[2], r[3]); w.z = pk2(r[4], r[5]); w.w = pk2(r[6], r[7]);
                *(u32x4*)rowp = w;
            }
    }
};
struct EpiResidual {
    static constexpr bool PERM = false, AFTER_DRAIN = false, VTOK = false;
    float* X; int ldc; float scale;
    __device__ __forceinline__ void operator()(const pg8::f32x4 (&acc)[2][2][4][2], const pg8::Unit& u, int wr, int wc, int fr, int fq) const {
        const int row0 = u.pm * 256 + wr * 64 + fr;
        const int col0 = u.pn * 256 + wc * 32 + 4 * fq;
#pragma unroll
        for (int ai = 0; ai < 2; ++ai)
#pragma unroll
            for (int m = 0; m < 4; ++m) {
                float* rowp = X + (size_t)(row0 + ai * 128 + m * 16) * ldc + col0;
#pragma unroll
                for (int bj = 0; bj < 2; ++bj)
#pragma unroll
                    for (int n = 0; n < 2; ++n) {
                        f32x4* p = (f32x4*)(rowp + bj * 128 + n * 16);
                        f32x4 v = *p; const pg8::f32x4 a = acc[ai][bj][m][n];
                        v[0] += scale * a[0]; v[1] += scale * a[1]; v[2] += scale * a[2]; v[3] += scale * a[3];
                        *p = v;
                    }
            }
    }
};

__device__ __forceinline__ void tr_item(const float* W, int ldw, int col0, int k0, bf16* WT, int K, int drow0, float* scr, int lane) {
#pragma unroll 8
    for (int i = 0; i < 32; ++i) { const int kk = 2 * i + (lane >> 5); scr[kk * 33 + (lane & 31)] = W[(size_t)(k0 + kk) * ldw + col0 + (lane & 31)]; }
    asm volatile("s_waitcnt lgkmcnt(0)" ::: "memory");
    const int c = lane & 7;
#pragma unroll
    for (int j = 0; j < 4; ++j) {
        const int n = (lane >> 3) + 8 * j; const float* s = scr + (8 * c) * 33 + n;
        u32x4 o; o.x = pk2(s[0 * 33], s[1 * 33]); o.y = pk2(s[2 * 33], s[3 * 33]); o.z = pk2(s[4 * 33], s[5 * 33]); o.w = pk2(s[6 * 33], s[7 * 33]);
        *(u32x4*)(WT + (size_t)(drow0 + n) * K + k0 + 8 * c) = o;
    }
    asm volatile("s_waitcnt lgkmcnt(0)" ::: "memory");
}

struct Params { const float* in[28]; float* out; unsigned char* ws; };
enum { I_X = 0, I_POS, I_GAINS, I_FG, I_FU, I_FD, I_EWIN, I_ECONV, I_EMU, I_W0, I_WUP, I_A0, I_AUP, I_GUP, I_KK, I_KA, I_RK, I_LNW, I_LNB, I_EWOUT,
       I_OWIN, I_QAN, I_KVAN, I_WQUP, I_WKVUP, I_QN, I_KN, I_OWOUT };

__device__ __forceinline__ void convert_layer_weights(const Params& P, int layer, float* scr, int gw, int ngw, int lane) {
    unsigned char* ws = P.ws;
    const int idx = layer >> 1; const bool even = !(layer & 1);
    constexpr int N_GU = (2 * DFF / 32) * (DM / 64);
    constexpr int N_D = (DM / 32) * (DFF / 64);
    constexpr int N_EWIN = (EVEN_IN / 32) * (DM / 64);
    constexpr int N_SQ = (DM / 32) * (DM / 64);
    constexpr int N_OWIN = (ODD_IN / 32) * (DM / 64);
    constexpr int N_WQ = (1536 / 32) * (QRANK / 64);
    constexpr int N_WKV = (1024 / 32) * (KVRANK / 64);
    const int nmix = even ? (N_EWIN + N_SQ) : (N_OWIN + N_WQ + 2 * N_WKV + N_SQ);
    const int total = 2 * (N_GU + N_D) + nmix;
    for (int it = gw; it < total; it += ngw) {
        int r = it;
        if (r < 2 * (N_GU + N_D)) {
            const int ff = r / (N_GU + N_D); r -= ff * (N_GU + N_D);
            const size_t woff = (size_t)(layer * 2 + ff) * DM * DFF;
            if (r < N_GU) {
                const int nb = r % 176, kb = r / 176, nd = 32 * nb, pn = nd >> 8, within = nd & 255, sel = within >> 7;
                const float* src = (sel ? P.in[I_FU] : P.in[I_FG]) + woff;
                tr_item(src, DFF, 128 * pn + (within & 127), 64 * kb, (bf16*)(ws + (ff ? WS_WGU1 : WS_WGU0)), DM, nd, scr, lane);
            } else {
                r -= N_GU; const int nb = r % 32, kb = r / 32;
                tr_item(P.in[I_FD] + woff, DM, 32 * nb, 64 * kb, (bf16*)(ws + (ff ? WS_WD1 : WS_WD0)), DFF, 32 * nb, scr, lane);
            }
            continue;
        }
        r -= 2 * (N_GU + N_D);
        if (even) {
            if (r < N_EWIN) { const int nb = r % 101, kb = r / 101; tr_item(P.in[I_EWIN] + (size_t)idx * DM * EVEN_IN, EVEN_IN, 32 * nb, 64 * kb, (bf16*)(ws + WS_WIN), DM, 32 * nb, scr, lane); continue; }
            r -= N_EWIN;
            { const int nb = r % 32, kb = r / 32; tr_item(P.in[I_EWOUT] + (size_t)idx * DM * DM, DM, 32 * nb, 64 * kb, (bf16*)(ws + WS_WOUT), DM, 32 * nb, scr, lane); }
        } else {
            if (r < N_OWIN) { const int nb = r % 22, kb = r / 22; tr_item(P.in[I_OWIN] + (size_t)idx * DM * ODD_IN, ODD_IN, 32 * nb, 64 * kb, (bf16*)(ws + WS_WIN), DM, 32 * nb, scr, lane); continue; }
            r -= N_OWIN;
            if (r < N_WQ) { const int nb = r % 48, kb = r / 48; tr_item(P.in[I_WQUP] + (size_t)idx * QRANK * 1536, 1536, 32 * nb, 64 * kb, (bf16*)(ws + WS_WQ), QRANK, 32 * nb, scr, lane); continue; }
            r -= N_WQ;
            if (r < 2 * N_WKV) {
                const int sel = r / N_WKV; r -= sel * N_WKV;
                const int nb = r % 32, kb = r / 32, nd = 32 * nb;
                tr_item(P.in[I_WKVUP] + (size_t)idx * KVRANK * 2048, 2048, (nd >> 7) * 256 + sel * 128 + (nd & 127), 64 * kb, (bf16*)(ws + (sel ? WS_WV : WS_WK)), KVRANK, nd, scr, lane);
                continue;
            }
            r -= 2 * N_WKV;
            { const int nb = r % 32, kb = r / 32; tr_item(P.in[I_OWOUT] + (size_t)idx * DM * DM, DM, 32 * nb, 64 * kb, (bf16*)(ws + WS_WOUT), DM, 32 * nb, scr, lane); }
        }
    }
}

__device__ __forceinline__ void rms_phase(const float* src, float* cpy, const float* gain, bf16* dst, int gw, int ngw, int lane) {
    f32x4 g[4];
#pragma unroll
    for (int j = 0; j < 4; ++j) g[j] = ((const f32x4*)gain)[lane + 64 * j];
    for (int m = 2 * gw; m < MTOK; m += 2 * ngw) {
        f32x4 v[2][4]; float s[2] = {0.f, 0.f};
#pragma unroll
        for (int u = 0; u < 2; ++u) { const f32x4* xr = (const f32x4*)(src + (size_t)(m + u) * DM) + lane;
#pragma unroll
            for (int j = 0; j < 4; ++j) v[u][j] = xr[64 * j]; }
#pragma unroll
        for (int u = 0; u < 2; ++u) {
#pragma unroll
            for (int j = 0; j < 4; ++j) s[u] += (v[u][j].x * v[u][j].x + v[u][j].y * v[u][j].y) + (v[u][j].z * v[u][j].z + v[u][j].w * v[u][j].w);
            if (cpy) { f32x4* cr = (f32x4*)(cpy + (size_t)(m + u) * DM) + lane;
#pragma unroll
                for (int j = 0; j < 4; ++j) cr[64 * j] = v[u][j]; }
        }
#pragma unroll
        for (int u = 0; u < 2; ++u) {
            const float rstd = rsqrtf(wave_sum(s[u]) * (1.f / DM) + NORM_EPS);
            u32x2* o8 = (u32x2*)(dst + (size_t)(m + u) * DM) + lane;
#pragma unroll
            for (int j = 0; j < 4; ++j) { u32x2 o; o.x = pk2(v[u][j].x * rstd * g[j].x, v[u][j].y * rstd * g[j].y); o.y = pk2(v[u][j].z * rstd * g[j].z, v[u][j].w * rstd * g[j].w); o8[64 * j] = o; }
        }
    }
}

__device__ __forceinline__ void conv_phase(const bf16* pconv, const float* cw, bf16* ycat, int gtid, int nthr) {
#pragma unroll 2
    for (int item = gtid; item < MTOK * 64; item += nthr) {
        const int m = item >> 6, c8 = (item & 63) * 8, t = m & (SEQ - 1);
        const bf16* row = pconv + (size_t)m * PCONV_LD;
        const u32x4 gb = *(const u32x4*)(row + c8), gc0 = *(const u32x4*)(row + 512 + c8), hi0 = *(const u32x4*)(row + 1024 + c8);
        const bf16* row1 = t >= 1 ? row - PCONV_LD : row; const bf16* row2 = t >= 2 ? row - 2 * PCONV_LD : row;
        u32x4 gc1 = *(const u32x4*)(row1 + 512 + c8), hi1 = *(const u32x4*)(row1 + 1024 + c8), gc2 = *(const u32x4*)(row2 + 512 + c8), hi2 = *(const u32x4*)(row2 + 1024 + c8);
        const unsigned k1 = t >= 1 ? 0xffffffffu : 0u, k2 = t >= 2 ? 0xffffffffu : 0u;
        gc1.x &= k1; gc1.y &= k1; gc1.z &= k1; gc1.w &= k1; gc2.x &= k2; gc2.y &= k2; gc2.z &= k2; gc2.w &= k2;
        float y[8];
#pragma unroll
        for (int e = 0; e < 4; ++e) {
            const float w0a = cw[c8 + 2 * e], w0b = cw[c8 + 2 * e + 1], w1a = cw[512 + c8 + 2 * e], w1b = cw[512 + c8 + 2 * e + 1], w2a = cw[1024 + c8 + 2 * e], w2b = cw[1024 + c8 + 2 * e + 1];
            const float u0a = bflo(gc0[e]) * bflo(hi0[e]), u0b = bfhi(gc0[e]) * bfhi(hi0[e]);
            const float u1a = bflo(gc1[e]) * bflo(hi1[e]), u1b = bfhi(gc1[e]) * bfhi(hi1[e]);
            const float u2a = bflo(gc2[e]) * bflo(hi2[e]), u2b = bfhi(gc2[e]) * bfhi(hi2[e]);
            y[2 * e] = bflo(gb[e]) * (w0a * u2a + w1a * u1a + w2a * u0a);
            y[2 * e + 1] = bfhi(gb[e]) * (w0b * u2b + w1b * u1b + w2b * u0b);
        }
        u32x4 o; o.x = pk2(y[0], y[1]); o.y = pk2(y[2], y[3]); o.z = pk2(y[4], y[5]); o.w = pk2(y[6], y[7]);
        *(u32x4*)(ycat + (size_t)m * DM + c8) = o;
    }
}

constexpr int PP_LIN_LD = 168;
constexpr int PP_CST = 8192, PP_GFR = 32768;
__device__ __forceinline__ float fast_sigmoid(float x) { return __builtin_amdgcn_rcpf(1.f + __expf(-x)); }
template <bool STORE> __device__ __forceinline__ void prep_phase(const Params& P, int idx, unsigned char* lds, int tid, int wave, int lane) {
    const int BIDX = bidx(), GDIMX = gdimx();
    const bf16* prw = (const bf16*)(P.ws + WS_PRW);
    bf16* ops = (bf16*)(P.ws + WS_OPS); bf16* gbuf = (bf16*)(P.ws + WS_GBUF); float* scal = (float*)(P.ws + WS_SCAL);
    const float* mu = P.in[I_EMU] + (size_t)idx * RW_COLS;
    const int fr = lane & 15, g = lane >> 4, h = wave;
    bf16* lin = (bf16*)lds; float* cst = (float*)(lds + PP_CST);
    cst[0 * 512 + tid] = P.in[I_W0][idx * 512 + tid]; cst[1 * 512 + tid] = P.in[I_A0][idx * 512 + tid]; cst[2 * 512 + tid] = P.in[I_KK][idx * 512 + tid]; cst[3 * 512 + tid] = P.in[I_KA][idx * 512 + tid];
    cst[4 * 512 + tid] = P.in[I_RK][idx * 512 + tid]; cst[5 * 512 + tid] = mu[tid]; cst[6 * 512 + tid] = mu[512 + tid]; cst[7 * 512 + tid] = mu[1024 + tid];
    bf16x8 wfr[4], afr[4];
    const float* wup = P.in[I_WUP] + (size_t)idx * 32 * 512; const float* aup = P.in[I_AUP] + (size_t)idx * 32 * 512; const float* gup = P.in[I_GUP] + (size_t)idx * 96 * 512;
#pragma unroll
    for (int nb = 0; nb < 4; ++nb) {
        const int col = 64 * h + 16 * nb + fr;
        u32x4 ww, aa;
        ww.x = pk2(wup[(8 * g + 0) * 512 + col], wup[(8 * g + 1) * 512 + col]); ww.y = pk2(wup[(8 * g + 2) * 512 + col], wup[(8 * g + 3) * 512 + col]);
        ww.z = pk2(wup[(8 * g + 4) * 512 + col], wup[(8 * g + 5) * 512 + col]); ww.w = pk2(wup[(8 * g + 6) * 512 + col], wup[(8 * g + 7) * 512 + col]);
        aa.x = pk2(aup[(8 * g + 0) * 512 + col], aup[(8 * g + 1) * 512 + col]); aa.y = pk2(aup[(8 * g + 2) * 512 + col], aup[(8 * g + 3) * 512 + col]);
        aa.z = pk2(aup[(8 * g + 4) * 512 + col], aup[(8 * g + 5) * 512 + col]); aa.w = pk2(aup[(8 * g + 6) * 512 + col], aup[(8 * g + 7) * 512 + col]);
        wfr[nb] = __builtin_bit_cast(bf16x8, ww); afr[nb] = __builtin_bit_cast(bf16x8, aa);
#pragma unroll
        for (int ks = 0; ks < 3; ++ks) {
            const int kb = 32 * ks + 8 * g; u32x4 gg_;
            gg_.x = pk2(gup[(kb + 0) * 512 + col], gup[(kb + 1) * 512 + col]); gg_.y = pk2(gup[(kb + 2) * 512 + col], gup[(kb + 3) * 512 + col]);
            gg_.z = pk2(gup[(kb + 4) * 512 + col], gup[(kb + 5) * 512 + col]); gg_.w = pk2(gup[(kb + 6) * 512 + col], gup[(kb + 7) * 512 + col]);
            *(u32x4*)(lds + PP_GFR + ((((h * 3 + ks) * 4 + nb) * 64 + lane) * 16)) = gg_;
        }
    }
    __syncthreads();
    for (int tile = BIDX; tile < MTOK / 16; tile += GDIMX) {
        const int m0 = tile * 16;
        if (tid < 320) {
            const int tok = tid / 20, ch = tid - tok * 20, m = m0 + tok, t = m & (SEQ - 1);
            const u32x4 wc = *(const u32x4*)(prw + (size_t)m * PRW_LD + 1536 + 8 * ch);
            const u32x4 wp = *(const u32x4*)(prw + (size_t)(t ? m - 1 : m) * PRW_LD + 1536 + 8 * ch);
            const f32x4 mu0 = *(const f32x4*)(mu + 1536 + 8 * ch), mu1 = *(const f32x4*)(mu + 1536 + 8 * ch + 4);
            float cur[8], prv[8], f[8]; unpack8(wc, cur); unpack8(wp, prv);
            const float mus[8] = {mu0.x, mu0.y, mu0.z, mu0.w, mu1.x, mu1.y, mu1.z, mu1.w};
#pragma unroll
            for (int e = 0; e < 8; ++e) {
                const float pv = t ? prv[e] : 0.f;
                const float x = cur[e] + (pv - cur[e]) * mus[e];
                const float th = 1.f - 2.f * __builtin_amdgcn_rcpf(1.f + __expf(2.f * x)), sg = fast_sigmoid(x);
                f[e] = ch < 4 ? th : (ch < 8 ? x : sg);
            }
            *(u32x4*)(lin + tok * PP_LIN_LD + 8 * ch) = pack8(f);
        }
        __syncthreads();
        const int m = m0 + fr, t = m & (SEQ - 1), b = m >> 12;
        const bf16* row = prw + (size_t)m * PRW_LD + 64 * h + 4 * g;
        u32x2 rc[4], kc[4], vc[4], rp[4], kp[4], vp[4];
#pragma unroll
        for (int nb = 0; nb < 4; ++nb) { rc[nb] = *(const u32x2*)(row + 16 * nb); kc[nb] = *(const u32x2*)(row + 512 + 16 * nb); vc[nb] = *(const u32x2*)(row + 1024 + 16 * nb); }
        {   const bf16* prow = t ? row - PRW_LD : row; const unsigned keep = t ? 0xffffffffu : 0u;
#pragma unroll
            for (int nb = 0; nb < 4; ++nb) { rp[nb] = *(const u32x2*)(prow + 16 * nb); kp[nb] = *(const u32x2*)(prow + 512 + 16 * nb); vp[nb] = *(const u32x2*)(prow + 1024 + 16 * nb);
                rp[nb].x &= keep; rp[nb].y &= keep; kp[nb].x &= keep; kp[nb].y &= keep; vp[nb].x &= keep; vp[nb].y &= keep; }
        }
        bf16x8 bfr[5];
#pragma unroll
        for (int ks = 0; ks < 5; ++ks) bfr[ks] = *(const bf16x8*)(lin + fr * PP_LIN_LD + 32 * ks + 8 * g);
        float ss = 0.f;
#pragma unroll
        for (int nb = 0; nb < 4; ++nb) {
            const int cb = 64 * h + 16 * nb + 4 * g;
            const f32x4 muk = *(const f32x4*)(cst + 6 * 512 + cb), kkc = *(const f32x4*)(cst + 2 * 512 + cb);
            const float c0 = bflo(kc[nb].x), c1 = bfhi(kc[nb].x), c2 = bflo(kc[nb].y), c3 = bfhi(kc[nb].y);
            const float p0 = bflo(kp[nb].x), p1 = bfhi(kp[nb].x), p2 = bflo(kp[nb].y), p3 = bfhi(kp[nb].y);
            const float q0 = (c0 + (p0 - c0) * muk.x) * kkc.x, q1 = (c1 + (p1 - c1) * muk.y) * kkc.y, q2 = (c2 + (p2 - c2) * muk.z) * kkc.z, q3 = (c3 + (p3 - c3) * muk.w) * kkc.w;
            ss += (q0 * q0 + q1 * q1) + (q2 * q2 + q3 * q3);
        }
        ss += shfl_xor_l(ss, lane, 16); ss += shfl_xor_l(ss, lane, 32);
        const float kinv = rsqrtf(fmaxf(ss, 1e-24f));
        float br = 0.f, kr = 0.f, rk = 0.f;
        bf16* op = ops + ((size_t)(b * NH + h) * (SEQ / 16) + (t >> 4)) * 6144 + lane * 4;
        bf16* gp = gbuf + ((size_t)tile * NH + h) * 1024 + lane * 4;
#pragma unroll
        for (int nb = 0; nb < 4; ++nb) {
            const int cb = 64 * h + 16 * nb + 4 * g;
            const f32x4 w0c = *(const f32x4*)(cst + 0 * 512 + cb), a0c = *(const f32x4*)(cst + 1 * 512 + cb), kkc = *(const f32x4*)(cst + 2 * 512 + cb), kac = *(const f32x4*)(cst + 3 * 512 + cb);
            const f32x4 rkc = *(const f32x4*)(cst + 4 * 512 + cb), mur = *(const f32x4*)(cst + 5 * 512 + cb), muv = *(const f32x4*)(cst + 7 * 512 + cb);
            const f32x4 muk = *(const f32x4*)(cst + 6 * 512 + cb);
            const pg8::f32x4 z0 = {0.f, 0.f, 0.f, 0.f};
            const pg8::f32x4 zw = __builtin_amdgcn_mfma_f32_16x16x32_bf16(wfr[nb], bfr[0], z0, 0, 0, 0);
            const pg8::f32x4 za = __builtin_amdgcn_mfma_f32_16x16x32_bf16(afr[nb], bfr[1], z0, 0, 0, 0);
            pg8::f32x4 gg = z0;
#pragma unroll
            for (int ks = 0; ks < 3; ++ks) gg = __builtin_amdgcn_mfma_f32_16x16x32_bf16(*(const bf16x8*)(lds + PP_GFR + ((((h * 3 + ks) * 4 + nb) * 64 + lane) * 16)), bfr[2 + ks], gg, 0, 0, 0);
            float o_um[4], o_wr[4], o_a[4], o_b[4], o_k[4], o_v[4], o_g[4];
#pragma unroll
            for (int r4 = 0; r4 < 4; ++r4) {
                const unsigned rcw = r4 < 2 ? rc[nb].x : rc[nb].y, rpw = r4 < 2 ? rp[nb].x : rp[nb].y, vcw = r4 < 2 ? vc[nb].x : vc[nb].y, vpw = r4 < 2 ? vp[nb].x : vp[nb].y;
                const unsigned kcw = r4 < 2 ? kc[nb].x : kc[nb].y, kpw = r4 < 2 ? kp[nb].x : kp[nb].y;
                const float kcur = (r4 & 1) ? bfhi(kcw) : bflo(kcw), kprev = (r4 & 1) ? bfhi(kpw) : bflo(kpw);
                const float rcur = (r4 & 1) ? bfhi(rcw) : bflo(rcw), rprev = (r4 & 1) ? bfhi(rpw) : bflo(rpw), vcur = (r4 & 1) ? bfhi(vcw) : bflo(vcw), vprev = (r4 & 1) ? bfhi(vpw) : bflo(vpw);
                const float r = rcur + (rprev - rcur) * mur[r4], v = vcur + (vprev - vcur) * muv[r4], k = kcur + (kprev - kcur) * muk[r4];
                const float nz = -(w0c[r4] + zw[r4]);
                const float sp = fmaxf(nz, 0.f) + __logf(1.f + __expf(-fabsf(nz)));
                const float e = __expf(-sp - 0.5f);
                const float wdec = __expf(-e), um = 1.f - wdec;
                const float iclr = fast_sigmoid(a0c[r4] + za[r4]);
                const float kk = k * kkc[r4] * kinv;
                const float kh = k * (1.f + (iclr - 1.f) * kac[r4]);
                const float bv = kk * iclr;
                br += bv * r; kr += kh * r; rk += r * kh * rkc[r4];
                o_um[r4] = um; o_wr[r4] = wdec * r; o_a[r4] = -kk; o_b[r4] = bv; o_k[r4] = kh; o_v[r4] = v; o_g[r4] = gg[r4];
            }
            u32x2 w2; if (STORE) {
            w2.x = pk2(o_um[0], o_um[1]); w2.y = pk2(o_um[2], o_um[3]); *(u32x2*)(op + (0 + nb) * 256) = w2;
            w2.x = pk2(o_wr[0], o_wr[1]); w2.y = pk2(o_wr[2], o_wr[3]); *(u32x2*)(op + (4 + nb) * 256) = w2;
            w2.x = pk2(o_a[0], o_a[1]); w2.y = pk2(o_a[2], o_a[3]); *(u32x2*)(op + (8 + nb) * 256) = w2;
            w2.x = pk2(o_b[0], o_b[1]); w2.y = pk2(o_b[2], o_b[3]); *(u32x2*)(op + (12 + nb) * 256) = w2;
            w2.x = pk2(o_k[0], o_k[1]); w2.y = pk2(o_k[2], o_k[3]); *(u32x2*)(op + (16 + nb) * 256) = w2;
            w2.x = pk2(o_v[0], o_v[1]); w2.y = pk2(o_v[2], o_v[3]); *(u32x2*)(op + (20 + nb) * 256) = w2;
            w2.x = pk2(o_g[0], o_g[1]); w2.y = pk2(o_g[2], o_g[3]); *(u32x2*)(gp + nb * 256) = w2; }
            else { asm volatile("" :: "v"(o_um[0] + o_wr[1] + o_a[2] + o_b[3] + o_k[0] + o_v[1] + o_g[2])); }
        }
        br += shfl_xor_l(br, lane, 16); br += shfl_xor_l(br, lane, 32);
        kr += shfl_xor_l(kr, lane, 16); kr += shfl_xor_l(kr, lane, 32);
        rk += shfl_xor_l(rk, lane, 16); rk += shfl_xor_l(rk, lane, 32);
        if (!STORE) { asm volatile("" :: "v"(br + kr + rk)); } else if (g == 0) { f32x4 s4 = {br, kr, rk, 0.f}; *(f32x4*)(scal + ((size_t)(b * NH + h) * SEQ + t) * 4) = s4; }
        __syncthreads();
    }
}

constexpr int SC_TC = 32, SC_STEP = 340, SC_BUF = SC_TC * SC_STEP;
struct StepOps { f32x4 W, WR, A, B, K; float v; f32x2 sc; };
__device__ __forceinline__ void sc_load(StepOps& o, const float* p, int wq, int row16) {
    o.W = *(const f32x4*)(p + wq); o.WR = *(const f32x4*)(p + 64 + wq); o.A = *(const f32x4*)(p + 128 + wq); o.B = *(const f32x4*)(p + 192 + wq); o.K = *(const f32x4*)(p + 256 + wq);
    o.v = p[320 + row16]; o.sc = *(const f32x2*)(p + 336);
}
__device__ __forceinline__ void scan_phase(const Params& P, float* lds, int tid, int wave, int lane) {
    const int BIDX = bidx(), GDIMX = gdimx();
    const bf16* ops = (const bf16*)(P.ws + WS_OPS); const float* scal = (const float*)(P.ws + WS_SCAL); float* yraw = (float*)(P.ws + WS_YRAW);
    float* buf0 = lds; float* ybuf0 = lds + 2 * SC_BUF;
    const int vcu = (GDIMX % 8 == 0) ? (BIDX % 8) * (GDIMX / 8) + BIDX / 8 : BIDX;
    for (int unit = vcu; unit < 256; unit += GDIMX) {
        const int bh = unit >> 2, rq = unit & 3, b = bh >> 3, hh = bh & 7;
        const bool loader = wave >= 4; const int ltid = tid - 256;
        const int ks = lane & 15, row16 = (wave & 3) * 4 + (lane >> 4), wq = 4 * ks;
        float s0 = 0.f, s1 = 0.f, s2 = 0.f, s3 = 0.f;
        const int ydelta = row16 * 8 + (ks & 7);
        u32x4 ld_[6]; f32x4 sc4_ = {0.f, 0.f, 0.f, 0.f};
#define SC_LOAD(c) do { const int t0_ = (c) * SC_TC; const bf16* src_ = ops + ((size_t)bh * (SEQ / 16) + (t0_ >> 4)) * 6144; \
            _Pragma("unroll") for (int i = 0; i < 6; ++i) ld_[i] = *(const u32x4*)(src_ + (size_t)(ltid + 256 * i) * 8); \
            if (ltid < 32) sc4_ = *(const f32x4*)(scal + ((size_t)bh * SEQ + t0_ + ltid) * 4); } while (0)
#define SC_WRITE(c) do { float* bufw = buf0 + ((c) & 1) * SC_BUF; \
            _Pragma("unroll") for (int i = 0; i < 6; ++i) { const int id = ltid + 256 * i, tl = id / 768, rem = id - tl * 768, vec = rem >> 7, r2 = rem & 127, nb = r2 >> 5, lp = r2 & 31; \
                const int tk = tl * 16 + ((2 * lp) & 15), gq = (2 * lp) >> 4;        \
                f32x4 lo_ = {bflo(ld_[i].x), bfhi(ld_[i].x), bflo(ld_[i].y), bfhi(ld_[i].y)}, hi_ = {bflo(ld_[i].z), bfhi(ld_[i].z), bflo(ld_[i].w), bfhi(ld_[i].w)}; \
                if (vec == 0) { lo_ = 1.f - lo_; hi_ = 1.f - hi_; } \
                if (vec < 5) { float* d_ = bufw + tk * SC_STEP + vec * 64 + 16 * nb + 4 * gq; *(f32x4*)d_ = lo_; *(f32x4*)(d_ + SC_STEP) = hi_; } \
                else if (nb == rq) { float* d_ = bufw + tk * SC_STEP + 320 + 4 * gq; *(f32x4*)d_ = lo_; *(f32x4*)(d_ + SC_STEP) = hi_; } } \
            if (ltid < 32) { f32x2 s2_ = {sc4_.x * 0.125f, sc4_.y * 0.125f}; *(f32x2*)(bufw + ltid * SC_STEP + 336) = s2_; } } while (0)
#define SC_YOUT(c) do { const float* yb_ = ybuf0 + ((c) & 1) * (SC_TC * 128); const int t0_ = (c) * SC_TC; \
            _Pragma("unroll") for (int i = 0; i < 2; ++i) { const int id = ltid + 256 * i; \
                const f32x4 pa_ = *(const f32x4*)(yb_ + id * 8), pb_ = *(const f32x4*)(yb_ + id * 8 + 4);        \
                yraw[((size_t)(bh * 4 + rq) * SEQ + t0_) * 16 + id] = ((pa_.x + pa_.y) + (pa_.z + pa_.w)) + ((pb_.x + pb_.y) + (pb_.z + pb_.w)); } } while (0)
        constexpr int NCH = SEQ / SC_TC;
        if (loader) { SC_LOAD(0); SC_WRITE(0); SC_LOAD(1); }
        __syncthreads();
        for (int c = 0; c < NCH; ++c) {
            if (loader) {
                if (c + 1 < NCH) SC_WRITE(c + 1);
                if (c + 2 < NCH) SC_LOAD(c + 2);
                if (c > 0) SC_YOUT(c - 1);
            } else {
                __builtin_amdgcn_s_setprio(1);
                const float* bufr = buf0 + (c & 1) * SC_BUF; float* ybl = ybuf0 + (c & 1) * (SC_TC * 128) + ydelta;
                StepOps cur, nxt;
                sc_load(cur, bufr, wq, row16);
#pragma unroll 4
                for (int st = 0; st < SC_TC; ++st) {
                    sc_load(nxt, bufr + (st + 1 < SC_TC ? st + 1 : st) * SC_STEP, wq, row16);
                    float da = s0 * cur.A.x + s1 * cur.A.y + s2 * cur.A.z + s3 * cur.A.w;
                    float dy = s0 * cur.WR.x + s1 * cur.WR.y + s2 * cur.WR.z + s3 * cur.WR.w;
                    da = row16_sum(da); dy += dpp_f<0x128>(dy);
                    s0 = s0 * cur.W.x + da * cur.B.x + cur.v * cur.K.x;
                    s1 = s1 * cur.W.y + da * cur.B.y + cur.v * cur.K.y;
                    s2 = s2 * cur.W.z + da * cur.B.z + cur.v * cur.K.z;
                    s3 = s3 * cur.W.w + da * cur.B.w + cur.v * cur.K.w;
                    const float y = dy + da * cur.sc.x + cur.v * cur.sc.y;
                    ybl[st * 128] = y;
                    cur = nxt;
                }
                __builtin_amdgcn_s_setprio(0);
            }
            __syncthreads();
        }
        if (loader) SC_YOUT(NCH - 1);
        __syncthreads();
#undef SC_LOAD
#undef SC_WRITE
#undef SC_YOUT
    }
}

__device__ __forceinline__ void post_phase(const Params& P, int idx, unsigned char* lds, int gw, int ngw, int wave, int lane) {
    const float* yraw = (const float*)(P.ws + WS_YRAW); const bf16* ops = (const bf16*)(P.ws + WS_OPS); const float* scal = (const float*)(P.ws + WS_SCAL);
    const bf16* gbuf = (const bf16*)(P.ws + WS_GBUF); bf16* ycat = (bf16*)(P.ws + WS_H);
    const int fr = lane & 15, g = lane >> 4;
    unsigned char* stg = lds + wave * 2304;
    for (int task = gw; task < (MTOK / 16) * NH; task += ngw) {
        const int tile = task >> 3, h = task & 7, m = tile * 16 + fr, t = m & (SEQ - 1), b = m >> 12, bh = b * NH + h;
        f32x4 y[4], lw[4], lb[4]; u32x2 vv[4], gg[4];
#pragma unroll
        for (int nb = 0; nb < 4; ++nb) {
            y[nb] = *(const f32x4*)(yraw + ((size_t)(bh * 4 + nb) * SEQ + t) * 16 + 4 * g);
            vv[nb] = *(const u32x2*)(ops + ((size_t)bh * (SEQ / 16) + (t >> 4)) * 6144 + (20 + nb) * 256 + lane * 4);
            gg[nb] = *(const u32x2*)(gbuf + ((size_t)tile * NH + h) * 1024 + nb * 256 + lane * 4);
            lw[nb] = *(const f32x4*)(P.in[I_LNW] + idx * 512 + h * 64 + 16 * nb + 4 * g);
            lb[nb] = *(const f32x4*)(P.in[I_LNB] + idx * 512 + h * 64 + 16 * nb + 4 * g);
        }
        const float rk = scal[((size_t)bh * SEQ + t) * 4 + 2];
        float sm = 0.f;
#pragma unroll
        for (int nb = 0; nb < 4; ++nb) sm += (y[nb].x + y[nb].y) + (y[nb].z + y[nb].w);
        sm += shfl_xor_l(sm, lane, 16); sm += shfl_xor_l(sm, lane, 32);
        const float mean = sm * (1.f / 64.f);
        float sv = 0.f;
#pragma unroll
        for (int nb = 0; nb < 4; ++nb) { y[nb] = y[nb] - mean; sv += (y[nb].x * y[nb].x + y[nb].y * y[nb].y) + (y[nb].z * y[nb].z + y[nb].w * y[nb].w); }
        sv += shfl_xor_l(sv, lane, 16); sv += shfl_xor_l(sv, lane, 32);
        const float rstd = rsqrtf(sv * (1.f / 64.f) + GN_EPS);
#pragma unroll
        for (int nb = 0; nb < 4; ++nb) {
            const float v0 = bflo(vv[nb].x), v1 = bfhi(vv[nb].x), v2 = bflo(vv[nb].y), v3 = bfhi(vv[nb].y);
            const float g0 = bflo(gg[nb].x), g1 = bfhi(gg[nb].x), g2 = bflo(gg[nb].y), g3 = bfhi(gg[nb].y);
            const float o0 = (y[nb].x * rstd * lw[nb].x + lb[nb].x + rk * v0) * g0, o1 = (y[nb].y * rstd * lw[nb].y + lb[nb].y + rk * v1) * g1;
            const float o2 = (y[nb].z * rstd * lw[nb].z + lb[nb].z + rk * v2) * g2, o3 = (y[nb].w * rstd * lw[nb].w + lb[nb].w + rk * v3) * g3;
            u32x2 w; w.x = pk2(o0, o1); w.y = pk2(o2, o3);
            *(u32x2*)(stg + fr * 144 + (16 * nb + 4 * g) * 2) = w;
        }
        asm volatile("s_waitcnt lgkmcnt(0)" ::: "memory");
#pragma unroll
        for (int i = 0; i < 2; ++i) { const int rowi = 8 * i + (lane >> 3), ch = lane & 7;
            const u32x4 w = *(const u32x4*)(stg + rowi * 144 + ch * 16);
            *(u32x4*)(ycat + (size_t)(tile * 16 + rowi) * DM + 512 + h * 64 + ch * 8) = w; }
        asm volatile("s_waitcnt lgkmcnt(0)" ::: "memory");
    }
}

__device__ __forceinline__ void mla_norm_phase(const Params& P, int idx, int gw, int ngw, int lane) {
    const bf16* podd = (const bf16*)(P.ws + WS_PODD); bf16* cqn = (bf16*)(P.ws + WS_CQN); bf16* ckvn = (bf16*)(P.ws + WS_CKVN); bf16* kpe = (bf16*)(P.ws + WS_KPE);
    float gq[8], gk[8];
    const int lq = lane < 48 ? lane : 0, lk = lane < 32 ? lane : 0, lp = lane < 8 ? lane : 0;
#pragma unroll
    for (int e = 0; e < 8; ++e) { gq[e] = P.in[I_QAN][idx * QRANK + 8 * lq + e]; gk[e] = P.in[I_KVAN][idx * KVRANK + 8 * lk + e]; }
    for (int m0 = 2 * gw; m0 < MTOK; m0 += 2 * ngw) {
        u32x4 wq[2], wk[2], wp[2];
#pragma unroll
        for (int u = 0; u < 2; ++u) { const bf16* row = podd + (size_t)(m0 + u) * PODD_LD;
            wq[u] = *(const u32x4*)(row + 8 * lq); wk[u] = *(const u32x4*)(row + QRANK + 8 * lk); wp[u] = *(const u32x4*)(row + QRANK + KVRANK + 8 * lp); }
#pragma unroll
        for (int u = 0; u < 2; ++u) { const int m = m0 + u;
            float q[8], k[8]; unpack8(wq[u], q); unpack8(wk[u], k);
            float sq = 0.f, sk = 0.f;
#pragma unroll
            for (int e = 0; e < 8; ++e) { sq += q[e] * q[e]; sk += k[e] * k[e]; }
            sq = lane < 48 ? sq : 0.f; sk = lane < 32 ? sk : 0.f;
            const float rq = rsqrtf(wave_sum(sq) * (1.f / QRANK) + NORM_EPS), rk = rsqrtf(wave_sum(sk) * (1.f / KVRANK) + NORM_EPS);
#pragma unroll
            for (int e = 0; e < 8; ++e) { q[e] *= rq * gq[e]; k[e] *= rk * gk[e]; }
            if (lane < 48) *(u32x4*)(cqn + (size_t)m * QRANK + 8 * lane) = pack8(q);
            if (lane < 32) *(u32x4*)(ckvn + (size_t)m * KVRANK + 8 * lane) = pack8(k);
            if (lane < 8) *(u32x4*)(kpe + (size_t)m * 64 + 8 * lane) = wp[u]; }
    }
}

constexpr float ATTN_C2 = 0.07216878364870322f * 1.4426950408889634f;
__device__ __forceinline__ void qk_prep_phase(const Params& P, int idx, unsigned char* lds, int gw, int ngw, int wave, int lane) {
    bf16* qb = (bf16*)(P.ws + WS_QB); const bf16* knope = (const bf16*)(P.ws + WS_KNOPE); const bf16* kpe = (const bf16*)(P.ws + WS_KPE); bf16* kf = (bf16*)(P.ws + WS_KF);
    const int* pos = (const int*)P.in[I_POS];
    const int h = lane >> 3, s = lane & 7;
    float qg[24], kg[24];
#pragma unroll
    for (int e = 0; e < 16; ++e) { qg[e] = P.in[I_QN][idx * QKD + 16 * s + e]; kg[e] = P.in[I_KN][idx * QKD + 16 * s + e]; }
#pragma unroll
    for (int e = 0; e < 8; ++e) { qg[16 + e] = P.in[I_QN][idx * QKD + 128 + 8 * s + e]; kg[16 + e] = P.in[I_KN][idx * QKD + 128 + 8 * s + e]; }
    float* cst = (float*)(lds + wave * 256);
    const float inv_freq = powf(10000.f, -(float)(lane & 31) * (1.f / 32.f));
    const float sgn = s < 4 ? -1.f : 1.f;
    for (int m = gw; m < MTOK; m += ngw) {
        bf16* qrow = qb + (size_t)m * 1536 + h * QKD; const bf16* krow = knope + (size_t)m * 1024 + h * 128;
        const u32x4 qa = *(const u32x4*)(qrow + 16 * s), qc = *(const u32x4*)(qrow + 16 * s + 8), qr = *(const u32x4*)(qrow + 128 + 8 * s);
        const u32x4 ka = *(const u32x4*)(krow + 16 * s), kc = *(const u32x4*)(krow + 16 * s + 8), kr = *(const u32x4*)(kpe + (size_t)m * 64 + 8 * s);
        {
            const float ang = (float)pos[m] * inv_freq;
            const float n = rintf(ang * 0.15915494309189535f);
            float rr = fmaf(-n, 6.28318548202514648f, ang); rr = fmaf(-n, -1.7484555e-7f, rr);
            if (lane < 32) { cst[lane] = __cosf(rr); cst[32 + lane] = __sinf(rr); }
        }
        asm volatile("s_waitcnt lgkmcnt(0)" ::: "memory");
        float cs[8], sn[8];
        { const f32x4 c0 = *(const f32x4*)(cst + 8 * (s & 3)), c1 = *(const f32x4*)(cst + 8 * (s & 3) + 4), s0 = *(const f32x4*)(cst + 32 + 8 * (s & 3)), s1 = *(const f32x4*)(cst + 32 + 8 * (s & 3) + 4);
          cs[0] = c0.x; cs[1] = c0.y; cs[2] = c0.z; cs[3] = c0.w; cs[4] = c1.x; cs[5] = c1.y; cs[6] = c1.z; cs[7] = c1.w;
          sn[0] = s0.x; sn[1] = s0.y; sn[2] = s0.z; sn[3] = s0.w; sn[4] = s1.x; sn[5] = s1.y; sn[6] = s1.z; sn[7] = s1.w; }
#pragma unroll
        for (int which = 0; which < 2; ++which) {
            float x0[8], x1[8], xr[8];
            unpack8(which ? ka : qa, x0); unpack8(which ? kc : qc, x1); unpack8(which ? kr : qr, xr);
            float ss = 0.f;
#pragma unroll
            for (int e = 0; e < 8; ++e) ss += x0[e] * x0[e] + x1[e] * x1[e] + xr[e] * xr[e];
            ss += shfl_xor_l(ss, lane, 1); ss += shfl_xor_l(ss, lane, 2); ss += shfl_xor_l(ss, lane, 4);
            const float rn = rsqrtf(ss * (1.f / QKD) + NORM_EPS) * (which ? 1.f : ATTN_C2);
            float o0[8], o1[8], orr[8];
#pragma unroll
            for (int e = 0; e < 8; ++e) {
                const float g0 = which ? kg[e] : qg[e], g1 = which ? kg[8 + e] : qg[8 + e], g2 = which ? kg[16 + e] : qg[16 + e];
                o0[e] = x0[e] * rn * g0; o1[e] = x1[e] * rn * g1;
                const float val = xr[e] * rn * g2;
                const float par = shfl_xor_l(val, lane, 4);
                orr[e] = val * cs[e] + sgn * par * sn[e];
            }
            bf16* orow = which ? kf + (size_t)m * 1536 + h * QKD : qrow;
            *(u32x4*)(orow + 16 * s) = pack8(o0); *(u32x4*)(orow + 16 * s + 8) = pack8(o1); *(u32x4*)(orow + 128 + 8 * s) = pack8(orr);
        }
    }
}

constexpr int AT_KB = 64 * QKD * 2, AT_VB = VD * 64 * 2;
__device__ __forceinline__ void attn_phase(const Params& P, unsigned char* lds, int tid, int wave, int lane) {
    const int BIDX = bidx(), GDIMX = gdimx();
    const bf16* Q = (const bf16*)(P.ws + WS_QB); const bf16* Kf = (const bf16*)(P.ws + WS_KF); const bf16* VT = (const bf16*)(P.ws + WS_VT); bf16* O = (bf16*)(P.ws + WS_H);
    const int fr = lane & 15, g = lane >> 4;
    LAS unsigned char* ldsl = (LAS unsigned char*)lds;
    const int vcu = (GDIMX % 8 == 0) ? (BIDX % 8) * (GDIMX / 8) + BIDX / 8 : BIDX;
    for (int unit = vcu; unit < 1024; unit += GDIMX) {
        const int v = unit & 255, ui = unit >> 8, bh = v >> 2, s = v & 3;
        const int qb = (ui == 0) ? s : (ui == 1) ? 7 - s : (ui == 2) ? 8 + s : 15 - s;
        const int b = bh >> 3, h = bh & 7, q0 = qb * 256, NT = (q0 + 256) / 64;
        const size_t bT = (size_t)b * SEQ;
        bf16x8 qf[2][6];
#pragma unroll
        for (int qi = 0; qi < 2; ++qi)
#pragma unroll
            for (int ks = 0; ks < 6; ++ks) qf[qi][ks] = *(const bf16x8*)(Q + (bT + q0 + 32 * wave + 16 * qi + fr) * 1536 + h * QKD + 32 * ks + 8 * g);
        pg8::f32x4 oacc[8][2];
#pragma unroll
        for (int db = 0; db < 8; ++db) { oacc[db][0] = (pg8::f32x4){0.f, 0.f, 0.f, 0.f}; oacc[db][1] = (pg8::f32x4){0.f, 0.f, 0.f, 0.f}; }
        float mrun[2] = {-1e30f, -1e30f}, lsum[2] = {0.f, 0.f};
#define AT_KDMA(j, bufi) do { \
            _Pragma("unroll") for (int i = 0; i < 3; ++i) { const int blk = wave + 8 * i, kb_ = blk / 6, ks_ = blk - kb_ * 6; \
                __builtin_amdgcn_global_load_lds((const unsigned*)(Kf + (bT + 64 * (j) + 16 * kb_ + fr) * 1536 + h * QKD + 32 * ks_ + 8 * g), (LAS unsigned*)(ldsl + (bufi) * AT_KB + blk * 1024), 16, 0, 0); } } while (0)
#define AT_VDMA(j, bufi) do { \
            _Pragma("unroll") for (int i = 0; i < 2; ++i) { const int blk = wave + 8 * i; \
                __builtin_amdgcn_global_load_lds((const unsigned*)(VT + (size_t)(h * VD + 16 * (blk >> 1) + fr) * MTOK + bT + 64 * (j) + 32 * (blk & 1) + 8 * g), (LAS unsigned*)(ldsl + 2 * AT_KB + (bufi) * AT_VB + blk * 1024), 16, 0, 0); } } while (0)
#define AT_VFRAG(dst, vb, db) do { \
            dst[0] = *(const u32x4*)((vb) + ((((db) * 2 + 0) * 4 + g) * 16 + fr) * 16); dst[1] = *(const u32x4*)((vb) + ((((db) * 2 + 1) * 4 + g) * 16 + fr) * 16); } while (0)
#define AT_PV(vb) do { u32x4 vfr_[2][2]; AT_VFRAG(vfr_[0], vb, 0); \
            _Pragma("unroll") for (int db = 0; db < 8; ++db) { \
                if (db + 1 < 8) AT_VFRAG(vfr_[(db + 1) & 1], vb, db + 1); \
                __builtin_amdgcn_sched_barrier(0); \
                _Pragma("unroll") for (int k2 = 0; k2 < 2; ++k2) { \
                    const bf16x8 vfrag_ = __builtin_bit_cast(bf16x8, vfr_[db & 1][k2]); \
                    oacc[db][0] = __builtin_amdgcn_mfma_f32_16x16x32_bf16(vfrag_, pf[0][k2], oacc[db][0], 0, 0, 0); \
                    oacc[db][1] = __builtin_amdgcn_mfma_f32_16x16x32_bf16(vfrag_, pf[1][k2], oacc[db][1], 0, 0, 0); } \
                __builtin_amdgcn_sched_barrier(0); } } while (0)
        const bool lag = wave >= 4; bool pend = false;
        bf16x8 pf[2][2];
#pragma unroll
        for (int qi = 0; qi < 2; ++qi) { pf[qi][0] = (bf16x8){0, 0, 0, 0, 0, 0, 0, 0}; pf[qi][1] = (bf16x8){0, 0, 0, 0, 0, 0, 0, 0}; }
        AT_KDMA(0, 0);
        AT_VDMA(0, 0);
        asm volatile("s_waitcnt vmcnt(0) lgkmcnt(0)" ::: "memory");
        __syncthreads();
        int vi = 0, vprev = 2, vnext = 1;
        for (int j = 0; j < NT; ++j) {
            if (j + 1 < NT) { AT_KDMA(j + 1, (j + 1) & 1); AT_VDMA(j + 1, vnext); }
            const unsigned char* kb = lds + (j & 1) * AT_KB; const unsigned char* vb = lds + 2 * AT_KB + vi * AT_VB;
            if (pend) { const unsigned char* vbp = lds + 2 * AT_KB + vprev * AT_VB; AT_PV(vbp); pend = false; }
            if (64 * j <= q0 + 32 * wave + 31) {
                pg8::f32x4 sacc[4][2];
#pragma unroll
                for (int kb4 = 0; kb4 < 4; ++kb4) { sacc[kb4][0] = (pg8::f32x4){0.f, 0.f, 0.f, 0.f}; sacc[kb4][1] = (pg8::f32x4){0.f, 0.f, 0.f, 0.f}; }
                bf16x8 kfr[2][4];
#pragma unroll
                for (int kb4 = 0; kb4 < 4; ++kb4) kfr[0][kb4] = *(const bf16x8*)(kb + ((((kb4 * 6 + 0) * 4 + g) * 16 + fr) * 16));
#pragma unroll
                for (int ks = 0; ks < 6; ++ks) {
                    if (ks + 1 < 6) {
#pragma unroll
                        for (int kb4 = 0; kb4 < 4; ++kb4) kfr[(ks + 1) & 1][kb4] = *(const bf16x8*)(kb + ((((kb4 * 6 + ks + 1) * 4 + g) * 16 + fr) * 16));
                    }
                    __builtin_amdgcn_sched_barrier(0);
#pragma unroll
                    for (int kb4 = 0; kb4 < 4; ++kb4) {
                        sacc[kb4][0] = __builtin_amdgcn_mfma_f32_16x16x32_bf16(kfr[ks & 1][kb4], qf[0][ks], sacc[kb4][0], 0, 0, 0);
                        sacc[kb4][1] = __builtin_amdgcn_mfma_f32_16x16x32_bf16(kfr[ks & 1][kb4], qf[1][ks], sacc[kb4][1], 0, 0, 0);
                    }
                    __builtin_amdgcn_sched_barrier(0);
                }
                if (j >= NT - 4) {
#pragma unroll
                    for (int qi = 0; qi < 2; ++qi) { const int qpos = q0 + 32 * wave + 16 * qi + fr;
#pragma unroll
                        for (int kb4 = 0; kb4 < 4; ++kb4)
#pragma unroll
                            for (int r = 0; r < 4; ++r) if (64 * j + 16 * kb4 + 4 * g + r > qpos) sacc[kb4][qi][r] = -1e30f; }
                }
#pragma unroll
                for (int qi = 0; qi < 2; ++qi) {
                    float mx = -1e30f;
#pragma unroll
                    for (int kb4 = 0; kb4 < 4; ++kb4)
#pragma unroll
                        for (int r = 0; r < 4; ++r) mx = fmaxf(mx, sacc[kb4][qi][r]);
                    mx = fmaxf(mx, shfl_xor_l(mx, lane, 16)); mx = fmaxf(mx, shfl_xor_l(mx, lane, 32));
                    const float mnew = fmaxf(mrun[qi], mx);
                    const float alpha = __builtin_amdgcn_exp2f(mrun[qi] - mnew);
                    mrun[qi] = mnew;
                    float ps = 0.f;
#pragma unroll
                    for (int kb4 = 0; kb4 < 4; ++kb4)
#pragma unroll
                        for (int r = 0; r < 4; ++r) { const float p = __builtin_amdgcn_exp2f(sacc[kb4][qi][r] - mnew); sacc[kb4][qi][r] = p; ps += p; }
                    lsum[qi] = lsum[qi] * alpha + ps;
#pragma unroll
                    for (int db = 0; db < 8; ++db) { oacc[db][qi][0] *= alpha; oacc[db][qi][1] *= alpha; oacc[db][qi][2] *= alpha; oacc[db][qi][3] *= alpha; }
#pragma unroll
                    for (int k2 = 0; k2 < 2; ++k2) {
                        u32x4 w; w.x = pk2(sacc[2 * k2][qi][0], sacc[2 * k2][qi][1]); w.y = pk2(sacc[2 * k2][qi][2], sacc[2 * k2][qi][3]);
                        w.z = pk2(sacc[2 * k2 + 1][qi][0], sacc[2 * k2 + 1][qi][1]); w.w = pk2(sacc[2 * k2 + 1][qi][2], sacc[2 * k2 + 1][qi][3]);
                        pf[qi][k2] = __builtin_bit_cast(bf16x8, w);
                    }
                }
                if (lag) pend = true; else AT_PV(vb);
            }
            asm volatile("s_waitcnt vmcnt(0) lgkmcnt(0)" ::: "memory");
            __syncthreads();
            { const int t_ = vprev; vprev = vi; vi = vnext; vnext = t_; }
        }
        if (pend) { const unsigned char* vbp = lds + 2 * AT_KB + vprev * AT_VB; AT_PV(vbp); }
#pragma unroll
        for (int qi = 0; qi < 2; ++qi) {
            float l = lsum[qi]; l += shfl_xor_l(l, lane, 16); l += shfl_xor_l(l, lane, 32);
            const float inv = 1.f / l;
            bf16* orow = O + (bT + q0 + 32 * wave + 16 * qi + fr) * DM + h * VD + 4 * g;
#pragma unroll
            for (int db = 0; db < 8; ++db) { u32x2 w; w.x = pk2(oacc[db][qi][0] * inv, oacc[db][qi][1] * inv); w.y = pk2(oacc[db][qi][2] * inv, oacc[db][qi][3] * inv); *(u32x2*)(orow + 16 * db) = w; }
        }
        asm volatile("s_waitcnt lgkmcnt(0)" ::: "memory");
        __syncthreads();
#undef AT_VFRAG
#undef AT_PV
#undef AT_KDMA
#undef AT_VDMA
    }
}

#define XB_TMO      128
#define XB_XCNT(j)  (256  + 64 * (j))
#define XB_XSUB(j)  (1280 + 64 * (j))
#define XB_XGEN(j)  (2304 + 64 * (j))
#define XB_TOP      3328
#define XB_TOPGEN   3392
#define XCD_BAR_WORDS 3456
#define XB_SPIN_CAP (1u << 18)

__device__ __forceinline__ unsigned xb_ld(unsigned* p)              { return __hip_atomic_load(p, __ATOMIC_RELAXED, __HIP_MEMORY_SCOPE_AGENT); }
__device__ __forceinline__ unsigned xb_add(unsigned* p, unsigned v) { return __hip_atomic_fetch_add(p, v, __ATOMIC_RELAXED, __HIP_MEMORY_SCOPE_AGENT); }
__device__ __forceinline__ unsigned xb_xcc_id() { return (unsigned)__builtin_amdgcn_s_getreg((3 << 11) | 20) & 0xFu; }
#define XB_SPIN(cond, bar) do { unsigned _sp = 0; while (cond) { __builtin_amdgcn_s_sleep(1); \
    if ((++_sp & 255u) == 0u) { if (xb_ld(&(bar)[XB_TMO])) break; if (_sp > XB_SPIN_CAP) { atomicAdd(&(bar)[XB_TMO], 1u); break; } } } } while (0)

struct XcdBarrier {
    unsigned* bar; unsigned x;
    volatile LAS unsigned* st;
};

__device__ __forceinline__ XcdBarrier xcd_barrier_post(unsigned* bar, volatile LAS unsigned* st) {
    XcdBarrier b; b.bar = bar; b.x = xb_xcc_id(); b.st = st;
    if (threadIdx.x == 0) (void)xb_add(&bar[XB_XCNT(b.x)], 1u);
    return b;
}
__device__ __forceinline__ void xcd_barrier_complete(unsigned* bar, unsigned x, unsigned& nloc, unsigned& nx) {
    const unsigned G = gridDim.x * gridDim.y * gridDim.z;
    unsigned sum, cnt, mine, sp = 0u;
    for (;;) {
        sum = 0u; cnt = 0u; mine = 0u;
#pragma unroll
        for (unsigned j = 0; j < 16; ++j) { const unsigned c = xb_ld(&bar[XB_XCNT(j)]); sum += c; cnt += (c > 0u) ? 1u : 0u; mine = (j == x) ? c : mine; }
        if (sum == G) break;
        __builtin_amdgcn_s_sleep(1);
        if ((++sp & 255u) == 0u) { if (xb_ld(&bar[XB_TMO])) break; if (sp > XB_SPIN_CAP) { atomicAdd(&bar[XB_TMO], 1u); break; } }
    }
    nloc = mine > 0u ? mine : 1u; nx = cnt > 0u ? cnt : 1u;
}

__device__ __forceinline__ void xcd_barrier(const XcdBarrier& b) {
    asm volatile("s_waitcnt vmcnt(0)" ::: "memory");
    __syncthreads();
    if (threadIdx.x == 0) {
        unsigned* bar = b.bar;
        __builtin_amdgcn_s_waitcnt(0);
        unsigned nloc = b.st[0], nx = b.st[1];
        if (nloc == 0u) { xcd_barrier_complete(bar, b.x, nloc, nx); b.st[0] = nloc; b.st[1] = nx; }
        const unsigned old = xb_add(&bar[XB_XSUB(b.x)], 1u);
        const unsigned gen = old / nloc;
        if (old + 1u == (gen + 1u) * nloc) {
            __builtin_amdgcn_fence(__ATOMIC_RELEASE, "agent");
            asm volatile("s_waitcnt vmcnt(0)" ::: "memory");
            const unsigned og = xb_add(&bar[XB_TOP], 1u);
            const unsigned tg = og / nx;
            if (og + 1u == (tg + 1u) * nx) xb_add(&bar[XB_TOPGEN], 1u);
            else XB_SPIN(xb_ld(&bar[XB_TOPGEN]) == tg, bar);
            __builtin_amdgcn_fence(__ATOMIC_ACQUIRE, "agent");
            xb_add(&bar[XB_XGEN(b.x)], 1u);
            asm volatile("s_waitcnt vmcnt(0)" ::: "memory");
        } else {
            XB_SPIN(xb_ld(&bar[XB_XGEN(b.x)]) == gen, bar);
            __builtin_amdgcn_fence(__ATOMIC_ACQUIRE, "agent");
            asm volatile("s_waitcnt vmcnt(0)" ::: "memory");
        }
    }
    __syncthreads();
}

#define GEMM_ARGS true, true
#ifndef REP_SCAN
#define REP_SCAN 1
#endif
#ifndef REP_ATTN
#define REP_ATTN 1
#endif
#ifndef REP_PREP
#define REP_PREP 1
#endif
#ifndef REP_SMALL
#define REP_SMALL 1
#endif
#define WSP() ({ size_t o_ = 0; asm volatile("" : "+s"(o_)); P.ws + o_; })
#define SYNC() do { XcdBarrier xb_; xb_.bar = (unsigned*)(WSP() + WS_CTL); xb_.x = xb_xcc_id(); xb_.st = (volatile LAS unsigned*)(lds_raw + LDS_MISC); xcd_barrier(xb_); asm volatile("" : "+s"(layer), "+s"(ff)); } while (0)
#define SYNC_CG() do { grid.sync(); asm volatile("" : "+s"(layer), "+s"(ff)); } while (0)
#define TIDS() int tid_ = threadIdx.x; asm volatile("" : "+v"(tid_)); const int tid = tid_, lane = tid & 63, wave = __builtin_amdgcn_readfirstlane(tid >> 6); const int G = gdimx(), bidx_ = bidx(), gw = bidx_ * NWAVES + wave, ngw = G * NWAVES; (void)bidx_; (void)lane; (void)gw; (void)ngw; (void)G
__global__ void __launch_bounds__(NTHR, 2) mega_fwd(Params P) {
    extern __shared__ __attribute__((aligned(16))) unsigned char lds_raw[];
    cg::grid_group grid = cg::this_grid();
    int ff = 0;
    if (threadIdx.x < 4) ((volatile LAS unsigned*)(lds_raw + LDS_MISC))[threadIdx.x] = 0u;
    __syncthreads();
    (void)xcd_barrier_post((unsigned*)(P.ws + WS_CTL), (volatile LAS unsigned*)(lds_raw + LDS_MISC));
#pragma unroll 1
    for (int layer = 0; layer < DEPTH; ++layer) {
        {
            TIDS(); unsigned char* ws = WSP();
#ifndef NO_CONV_W
            convert_layer_weights(P, layer, (float*)(lds_raw + wave * 16384), gw, ngw, lane);
#endif
            rms_phase(layer == 0 ? P.in[I_X] : P.out, layer == 0 ? P.out : nullptr, P.in[I_GAINS] + (size_t)layer * 3 * DM, (bf16*)(ws + WS_H), gw, ngw, lane);
        }
        { int never_ = 0; asm volatile("" : "+s"(never_)); if (never_) SYNC_CG(); }
        SYNC();
#pragma unroll 1
        for (ff = 0; ff < 2; ++ff) {
            if (ff == 1) { TIDS(); unsigned char* ws = WSP(); rms_phase(P.out, nullptr, P.in[I_GAINS] + (size_t)layer * 3 * DM + 2 * DM, (bf16*)(ws + WS_H), gw, ngw, lane); SYNC(); }
            {
                unsigned char* ws = WSP();
                pg8::Gemm g{(const bf16*)(ws + WS_H), (const bf16*)(ws + (ff ? WS_WGU1 : WS_WGU0)), MTOK, 2 * DFF, DM}; pg8::StaticOrder S; S.init(MTOK, 2 * DFF, gdimx(), bidx());
                EpiSwiGLU E{(bf16*)(ws + WS_ACT), DFF};

#ifndef NO_G_GU
pg8::gemm_phase<EpiSwiGLU, pg8::StaticOrder, GEMM_ARGS>((LAS unsigned char*)lds_raw, g, S, E);
#endif

            }
            SYNC();
            {
                unsigned char* ws = WSP();
                pg8::Gemm g{(const bf16*)(ws + WS_ACT), (const bf16*)(ws + (ff ? WS_WD1 : WS_WD0)), MTOK, DM, DFF}; pg8::StaticOrder S; S.init(MTOK, DM, gdimx(), bidx());
                EpiResidual E{P.out, DM, 0.5f};

#ifndef NO_G_D
pg8::gemm_phase<EpiResidual, pg8::StaticOrder, GEMM_ARGS>((LAS unsigned char*)lds_raw, g, S, E);
#endif

            }
            if (!(layer == DEPTH - 1 && ff == 1)) SYNC();
            if (ff == 0) {
                { TIDS(); unsigned char* ws = WSP(); rms_phase(P.out, nullptr, P.in[I_GAINS] + (size_t)layer * 3 * DM + DM, (bf16*)(ws + WS_H), gw, ngw, lane); }
                SYNC();
                {
                    unsigned char* ws = WSP();
                    const bool even = !(layer & 1);
                    const int N = even ? 3328 : 768;
                    pg8::Gemm g{(const bf16*)(ws + WS_H), (const bf16*)(ws + WS_WIN), MTOK, N, DM}; pg8::StaticOrder S; S.init(MTOK, N, gdimx(), bidx());
                    EpiStore E;
                    if (even) { E.O0 = (bf16*)(ws + WS_PCONV); E.ldc0 = PCONV_LD; E.ntile0 = 6; E.O1 = (bf16*)(ws + WS_PRW); E.ldc1 = PRW_LD; }
                    else { E.O0 = (bf16*)(ws + WS_PODD); E.ldc0 = PODD_LD; E.ntile0 = 1 << 20; E.O1 = (bf16*)(ws + WS_PODD); E.ldc1 = PODD_LD; }

#ifndef NO_G_WIN
pg8::gemm_phase<EpiStore, pg8::StaticOrder, GEMM_ARGS>((LAS unsigned char*)lds_raw, g, S, E);
#endif

                }
                SYNC();
                if (!(layer & 1)) {
#ifndef NO_CONV
                    { unsigned char* ws = WSP(); TIDS(); conv_phase((const bf16*)(ws + WS_PCONV), P.in[I_ECONV] + (size_t)(layer >> 1) * 3 * 512, (bf16*)(ws + WS_H), bidx_ * NTHR + tid, G * NTHR); }
#endif
                    SYNC();
#ifndef NO_PREP
                    for (int rep_ = 0; rep_ < REP_PREP; ++rep_) { TIDS(); prep_phase<true>(P, layer >> 1, lds_raw, tid, wave, lane); }
#if REP_PREP == 2
                    { TIDS(); prep_phase<false>(P, layer >> 1, lds_raw, tid, wave, lane); }
#endif
#if REP_PREP == 3
                    { TIDS(); prep_phase<true>(P, layer >> 1, lds_raw, tid, wave, lane); }
#endif
#endif
                    SYNC();
#ifndef NO_SCAN
                    for (int rep_ = 0; rep_ < REP_SCAN; ++rep_) { TIDS(); scan_phase(P, (float*)lds_raw, tid, wave, lane); }
#endif
                    SYNC();
#ifndef NO_POST
                    for (int rep_ = 0; rep_ < REP_SMALL; ++rep_) { TIDS(); post_phase(P, layer >> 1, lds_raw, gw, ngw, wave, lane); }
#endif
                    SYNC();
                } else {
#ifndef NO_MLAN
                    for (int rep_ = 0; rep_ < REP_SMALL; ++rep_) { TIDS(); mla_norm_phase(P, layer >> 1, gw, ngw, lane); }
#endif
                    SYNC();
#ifndef NO_G_3
                    {   unsigned char* ws = WSP();
                        pg8::Gemm g{(const bf16*)(ws + WS_CQN), (const bf16*)(ws + WS_WQ), MTOK, 1536, QRANK}; pg8::StaticOrder S; S.init(MTOK, 1536, gdimx(), bidx());
                        EpiStore E{(bf16*)(ws + WS_QB), 1536, 1 << 20, (bf16*)(ws + WS_QB), 1536};
                        pg8::gemm_phase<EpiStore, pg8::StaticOrder, GEMM_ARGS>((LAS unsigned char*)lds_raw, g, S, E); }
                    asm volatile("" : "+s"(layer), "+s"(ff));
                    {   unsigned char* ws = WSP();
                        pg8::Gemm g{(const bf16*)(ws + WS_CKVN), (const bf16*)(ws + WS_WK), MTOK, 1024, KVRANK}; pg8::StaticOrder S; S.init(MTOK, 1024, gdimx(), bidx());
                        EpiStore E{(bf16*)(ws + WS_KNOPE), 1024, 1 << 20, (bf16*)(ws + WS_KNOPE), 1024};
                        pg8::gemm_phase<EpiStore, pg8::StaticOrder, GEMM_ARGS>((LAS unsigned char*)lds_raw, g, S, E); }
                    asm volatile("" : "+s"(layer), "+s"(ff));
                    {   unsigned char* ws = WSP();
                        pg8::Gemm g{(const bf16*)(ws + WS_WV), (const bf16*)(ws + WS_CKVN), 1024, MTOK, KVRANK}; pg8::StaticOrder S; S.init(1024, MTOK, gdimx(), bidx());
                        EpiStoreV E; E.O0 = (bf16*)(ws + WS_VT); E.ldc0 = MTOK; E.ntile0 = 1 << 20; E.O1 = E.O0; E.ldc1 = MTOK;
                        pg8::gemm_phase<EpiStoreV, pg8::StaticOrder, false, true>((LAS unsigned char*)lds_raw, g, S, E); }
#endif
                    SYNC();
#ifndef NO_QKP
                    { TIDS(); qk_prep_phase(P, layer >> 1, lds_raw, gw, ngw, wave, lane); }
#endif
                    SYNC();
#ifndef NO_ATTN
                    for (int rep_ = 0; rep_ < REP_ATTN; ++rep_) { TIDS(); attn_phase(P, lds_raw, tid, wave, lane); }
#endif
                    SYNC();
                }
                {
                    unsigned char* ws = WSP();
                    pg8::Gemm g{(const bf16*)(ws + WS_H), (const bf16*)(ws + WS_WOUT), MTOK, DM, DM}; pg8::StaticOrder S; S.init(MTOK, DM, gdimx(), bidx());
                    EpiResidual E{P.out, DM, 1.0f};

#ifndef NO_G_OUT
pg8::gemm_phase<EpiResidual, pg8::StaticOrder, GEMM_ARGS>((LAS unsigned char*)lds_raw, g, S, E);
#endif

                }
                SYNC();
            }
        }
    }
}

extern "C" void kernel_launch(void* const* d_in, const int* in_sizes, int n_in, void* d_out, int out_size, void* d_ws, size_t ws_size, hipStream_t stream) {
    static int grid = 0;
    if (grid == 0) {
        if (n_in != 28 || out_size != MTOK * DM || ws_size < WS_END) { fprintf(stderr, "kernel_launch: unexpected problem (n_in %d, out %d, ws %zu < %zu)\n", n_in, out_size, ws_size, (size_t)WS_END); grid = -1; return; }
        int dev = 0, cus = 0, per_cu = 0;
        hipGetDevice(&dev); hipDeviceGetAttribute(&cus, hipDeviceAttributeMultiprocessorCount, dev);
        hipFuncSetAttribute((const void*)mega_fwd, hipFuncAttributeMaxDynamicSharedMemorySize, LDS_BYTES);
        hipOccupancyMaxActiveBlocksPerMultiprocessor(&per_cu, (const void*)mega_fwd, NTHR, LDS_BYTES);
        if (per_cu < 1) per_cu = 1;
        grid = cus * per_cu;
        (void)hipGetLastError();
    }
    if (grid < 0) return;
    if (hipMemsetAsync((char*)d_ws + WS_CTL, 0, CTL_BYTES, stream) != hipSuccess) { fprintf(stderr, "memset failed\n"); return; }
    Params p{};
    for (int i = 0; i < 28; ++i) p.in[i] = (const float*)d_in[i];
    p.out = (float*)d_out; p.ws = (unsigned char*)d_ws;
    void* args[] = {&p};
    hipError_t e = hipLaunchCooperativeKernel((const void*)mega_fwd, dim3(grid), dim3(NTHR), args, LDS_BYTES, stream);
    if (e != hipSuccess) fprintf(stderr, "cooperative launch failed: %s (grid %d)\n", hipGetErrorString(e), grid);
}
```

```cpp
#include <hip/hip_runtime.h>
#include <hip/hip_cooperative_groups.h>
#include <cstdio>
#include <cstdint>
namespace cg = cooperative_groups;
namespace pg8 {
#define PG8_LAS __attribute__((address_space(3)))
typedef unsigned short bf16_t;
typedef short bf16x8 __attribute__((ext_vector_type(8)));
typedef float f32x4 __attribute__((ext_vector_type(4)));
typedef unsigned u32x4 __attribute__((ext_vector_type(4)));
constexpr int BM = 256, BK = 64, HALF = 128, HTB = HALF * BK * 2  , STAGE_BYTES = 8 * HTB, NXCD = 8, WGM = 8;

__host__ __device__ __forceinline__ int lds_byte(int r, int c) { const int st = (r >> 4) * 2 + (c >> 5), rr = r & 15, cc = c & 31, ob = rr * 64 + cc * 2; return st * 1024 + (ob ^ (((ob >> 9) & 1) << 5)); }
__host__ __device__ __forceinline__ void stage_rc(int b, int& R, int& C) { const int st = b / 1024, sb = b % 1024, swz = sb ^ (((sb >> 9) & 1) << 5); R = (st >> 1) * 16 + swz / 64; C = (st & 1) * 32 + (swz % 64) / 2; }
__host__ __device__ __forceinline__ int perm32(int rho) { const int n = rho >> 4, i = rho & 15; return 8 * (i >> 2) + 4 * n + (i & 3); }

struct Unit { int pm, pn; };
struct Gemm { const bf16_t* A; const bf16_t* Bt; int M, N, K; };

struct StaticOrder {
    int nM, nN, nwg, G, c;
    __host__ __device__ void init(int M, int N, int G_, int c_) { nM = M / BM; nN = N / BM; nwg = nM * nN; G = G_; c = c_; }
    __host__ __device__ bool next(int i, Unit& u) const {
        const long L = (long)i * G + c; if (L >= nwg) return false;
        int wgid = (int)L; { const int q = nwg / NXCD, r = nwg % NXCD, xcd = wgid % NXCD, off = wgid / NXCD; wgid = (xcd < r ? xcd * (q + 1) : r * (q + 1) + (xcd - r) * q) + off; }
        const int nig = WGM * nN, gid = wgid / nig, fm = gid * WGM, gsz = (nM - fm) < WGM ? (nM - fm) : WGM;
        u.pm = fm + ((wgid % nig) % gsz); u.pn = (wgid % nig) / gsz; return true;
    }
    __device__ __forceinline__ void a_ready(const Unit&) const {}
    __device__ __forceinline__ void done(const Unit&) const {}
};

__device__ __forceinline__ unsigned cvt_pk_bf16(float lo, float hi) { unsigned r; asm volatile("v_cvt_pk_bf16_f32 %0, %1, %2" : "=v"(r) : "v"(lo), "v"(hi)); return r; }
typedef float f32x2 __attribute__((ext_vector_type(2)));
template <class Epi, class Sched, bool ALIGN_EPI = false, bool SP2 = false>
__device__ __forceinline__ void gemm_phase(PG8_LAS unsigned char* lds, const Gemm g, const Sched& S, const Epi& E) {
    int tid_ = threadIdx.x; asm volatile("" : "+v"(tid_));
    const int tid = tid_, wid = __builtin_amdgcn_readfirstlane(tid >> 6), lane = tid & 63, wr = wid >> 2, wc = wid & 3, fr = lane & 15, fq = lane >> 4;
    const int K = g.K, nt = K / BK;
    unsigned voffA[2], voffB[2];
#pragma unroll
    for (int i = 0; i < 2; ++i) { int R, C; stage_rc(tid * 16 + i * 8192, R, C); const int Rb0 = Epi::PERM ? ((R & ~31) + perm32(R & 31)) : R; const int Rb = Epi::VTOK ? ((Rb0 & ~31) + 16 * ((Rb0 >> 2) & 1) + 4 * ((Rb0 >> 3) & 3) + (Rb0 & 3)) : Rb0;
        voffA[i] = (unsigned)(R * K + C) * 2u; voffB[i] = (unsigned)(Rb * K + C) * 2u; }
    const size_t kstep = (size_t)(BK * 2);
    const size_t hstep = (size_t)HALF * K * 2;
    const size_t tstep = 2 * hstep;
    const unsigned ldsw = (unsigned)wid * 1024u;
    const int aoff = lds_byte(wr * 64 + fr, fq * 8), boff = lds_byte(wc * 32 + fr, fq * 8);
#define PG8_SA(b, h) (((b) * 2 + (h)) * HTB)
#define PG8_SB(b, h) ((4 + (b) * 2 + (h)) * HTB)
#define PG8_STAGE(bufoff, gbase, voff) do { _Pragma("unroll") for (int _i = 0; _i < 2; ++_i) \
        __builtin_amdgcn_global_load_lds((const unsigned*)((const char*)(gbase) + (voff)[_i]), (PG8_LAS unsigned*)(lds + (bufoff) + ldsw + _i * 8192), 16, 0, 0); } while (0)
#define PG8_LDA(dst, b, h) do { _Pragma("unroll") for (int m = 0; m < 4; ++m) _Pragma("unroll") for (int k = 0; k < 2; ++k) dst[m][k] = *(const PG8_LAS bf16x8*)(lds + PG8_SA(b, h) + aoff + m * 2048 + k * 1024); } while (0)
#define PG8_LDB(dst, b, h) do { _Pragma("unroll") for (int n = 0; n < 2; ++n) _Pragma("unroll") for (int k = 0; k < 2; ++k) dst[n][k] = *(const PG8_LAS bf16x8*)(lds + PG8_SB(b, h) + boff + n * 2048 + k * 1024); } while (0)
#define PG8_MMA(ai, bj, At, Bt) do { __builtin_amdgcn_s_setprio(1); _Pragma("unroll") for (int m = 0; m < 4; ++m) _Pragma("unroll") for (int n = 0; n < 2; ++n) _Pragma("unroll") for (int k = 0; k < 2; ++k) \
        acc[ai][bj][m][n] = __builtin_amdgcn_mfma_f32_16x16x32_bf16(Bt[n][k], At[m][k], acc[ai][bj][m][n], 0, 0, 0); __builtin_amdgcn_s_setprio(0); } while (0)
#define PG8_WAIT_V(n) asm volatile("s_waitcnt vmcnt(" #n ")" ::: "memory")
#define PG8_WAIT_L(n) asm volatile("s_waitcnt lgkmcnt(" #n ")" ::: "memory")
#define PG8_BAR __builtin_amdgcn_s_barrier()
#define PG8_SCHED __builtin_amdgcn_sched_barrier(0)
    Unit cur, nxt; int ui = 0;
    if (!S.next(0, cur)) return;
    f32x4 acc[2][2][4][2];
#pragma unroll
    for (int a = 0; a < 2; ++a)
#pragma unroll
        for (int b = 0; b < 2; ++b)
#pragma unroll
            for (int m = 0; m < 4; ++m)
#pragma unroll
                for (int n = 0; n < 2; ++n) acc[a][b][m][n] = (f32x4){0.f, 0.f, 0.f, 0.f};
    bf16x8 At[4][2], B0[2][2], B1[2][2];
    const char* cA = (const char*)g.A + (size_t)cur.pm * tstep; const char* cB = (const char*)g.Bt + (size_t)cur.pn * tstep;
    S.a_ready(cur);
    if constexpr (SP2) {
        PG8_STAGE(PG8_SB(0, 0), cB, voffB); PG8_STAGE(PG8_SB(0, 1), cB + hstep, voffB); PG8_STAGE(PG8_SA(0, 0), cA, voffA); PG8_STAGE(PG8_SA(0, 1), cA + hstep, voffA);
        if (wr == 1) PG8_BAR;
        PG8_WAIT_V(2); PG8_BAR;
        PG8_STAGE(PG8_SB(1, 0), cB + kstep, voffB); PG8_STAGE(PG8_SA(1, 0), cA + kstep, voffA); PG8_STAGE(PG8_SB(1, 1), cB + hstep + kstep, voffB);
        PG8_WAIT_V(6); PG8_BAR;
    } else {
        PG8_STAGE(PG8_SB(0, 0), cB, voffB); PG8_STAGE(PG8_SA(0, 0), cA, voffA); PG8_STAGE(PG8_SB(0, 1), cB + hstep, voffB); PG8_STAGE(PG8_SA(0, 1), cA + hstep, voffA);
        if (wr == 1) PG8_BAR;
        PG8_WAIT_V(4); PG8_BAR;
        PG8_STAGE(PG8_SB(1, 0), cB + kstep, voffB); PG8_STAGE(PG8_SA(1, 0), cA + kstep, voffA); PG8_STAGE(PG8_SB(1, 1), cB + hstep + kstep, voffB);
        PG8_WAIT_V(6); PG8_BAR;
    }
    for (;;) {
        const bool has_next = S.next(ui + 1, nxt);
        const char* nA = has_next ? (const char*)g.A + (size_t)nxt.pm * tstep : cA; const char* nB = has_next ? (const char*)g.Bt + (size_t)nxt.pn * tstep : cB;
        for (int t = 0; t < nt; t += 2) {
            const bool last = (t == nt - 2);
            const char* a1 = cA + (size_t)(t + 1) * kstep;
            const char* a2 = last ? nA : cA + (size_t)(t + 2) * kstep; const char* b2 = last ? nB : cB + (size_t)(t + 2) * kstep;
            const char* a3 = a2 + kstep; const char* b3 = b2 + kstep;
            if (last && has_next) S.a_ready(nxt);
            if constexpr (SP2) {
            PG8_LDB(B0, 0, 0); PG8_LDB(B1, 0, 1); PG8_SCHED; PG8_LDA(At, 0, 0); PG8_STAGE(PG8_SA(1, 1), a1 + hstep, voffA);
            PG8_WAIT_V(8); PG8_WAIT_L(0); PG8_BAR; PG8_MMA(0, 0, At, B0); PG8_MMA(0, 1, At, B1); PG8_BAR; PG8_SCHED;
            PG8_LDA(At, 0, 1); PG8_STAGE(PG8_SB(0, 0), b2, voffB); PG8_STAGE(PG8_SB(0, 1), b2 + hstep, voffB); PG8_STAGE(PG8_SA(0, 0), a2, voffA);
            PG8_WAIT_V(8); PG8_WAIT_L(0); PG8_BAR; PG8_MMA(1, 0, At, B0); PG8_MMA(1, 1, At, B1); PG8_BAR; PG8_SCHED;
            PG8_LDB(B0, 1, 0); PG8_LDB(B1, 1, 1); PG8_SCHED; PG8_LDA(At, 1, 0); PG8_STAGE(PG8_SA(0, 1), a2 + hstep, voffA);
            PG8_WAIT_V(8); PG8_WAIT_L(0); PG8_BAR; PG8_MMA(0, 0, At, B0); PG8_MMA(0, 1, At, B1); PG8_BAR; PG8_SCHED;
            PG8_LDA(At, 1, 1); PG8_STAGE(PG8_SB(1, 0), b3, voffB); PG8_STAGE(PG8_SB(1, 1), b3 + hstep, voffB); PG8_STAGE(PG8_SA(1, 0), a3, voffA);
            PG8_WAIT_V(8); PG8_WAIT_L(0); PG8_BAR; PG8_MMA(1, 0, At, B0); PG8_MMA(1, 1, At, B1); PG8_BAR; PG8_SCHED;
            } else {
            PG8_LDB(B0, 0, 0); PG8_SCHED; PG8_LDA(At, 0, 0); PG8_STAGE(PG8_SA(1, 1), a1 + hstep, voffA);
            PG8_WAIT_L(8); PG8_BAR; PG8_WAIT_L(0); PG8_MMA(0, 0, At, B0); PG8_BAR; PG8_SCHED;
            PG8_LDB(B1, 0, 1); PG8_STAGE(PG8_SB(0, 0), b2, voffB);
            PG8_BAR; PG8_WAIT_L(0); PG8_MMA(0, 1, At, B1); PG8_BAR;
            PG8_LDA(At, 0, 1); PG8_STAGE(PG8_SA(0, 0), a2, voffA);
            PG8_BAR; PG8_WAIT_L(0); PG8_MMA(1, 0, At, B0); PG8_BAR; PG8_SCHED;
            PG8_STAGE(PG8_SB(0, 1), b2 + hstep, voffB);
            PG8_WAIT_V(6); PG8_BAR; PG8_MMA(1, 1, At, B1); PG8_BAR;
            PG8_LDB(B0, 1, 0); PG8_SCHED; PG8_LDA(At, 1, 0); PG8_STAGE(PG8_SA(0, 1), a2 + hstep, voffA);
            PG8_WAIT_L(8); PG8_BAR; PG8_WAIT_L(0); PG8_MMA(0, 0, At, B0); PG8_BAR; PG8_SCHED;
            PG8_LDB(B1, 1, 1); PG8_STAGE(PG8_SB(1, 0), b3, voffB);
            PG8_BAR; PG8_WAIT_L(0); PG8_MMA(0, 1, At, B1); PG8_BAR;
            PG8_LDA(At, 1, 1); PG8_STAGE(PG8_SA(1, 0), a3, voffA);
            PG8_BAR; PG8_WAIT_L(0); PG8_MMA(1, 0, At, B0); PG8_BAR; PG8_SCHED;
            PG8_STAGE(PG8_SB(1, 1), b3 + hstep, voffB);
            PG8_WAIT_V(6); PG8_BAR; PG8_MMA(1, 1, At, B1); PG8_BAR;
            }
        }
        if constexpr (ALIGN_EPI) { if (wr == 0) PG8_BAR; }
        if constexpr (!Epi::AFTER_DRAIN) { E(acc, cur, wr, wc, fr, fq); S.done(cur); }
        if (!has_next) break;
#pragma unroll
        for (int a = 0; a < 2; ++a)
#pragma unroll
            for (int b = 0; b < 2; ++b)
#pragma unroll
                for (int m = 0; m < 4; ++m)
#pragma unroll
                    for (int n = 0; n < 2; ++n) acc[a][b][m][n] = (f32x4){0.f, 0.f, 0.f, 0.f};
        cur = nxt; cA = nA; cB = nB; ++ui;
        if constexpr (ALIGN_EPI) { if (wr == 1) PG8_BAR; }
    }
    PG8_WAIT_V(0);
    if constexpr (!ALIGN_EPI) { if (wr == 0) PG8_BAR; }
    PG8_BAR;
    if constexpr (Epi::AFTER_DRAIN) { E.fused(acc, cur, wr, wc, fr, fq, lds, wid, lane); S.done(cur); }
#undef PG8_SA
#undef PG8_SB
#undef PG8_STAGE
#undef PG8_LDA
#undef PG8_LDB
#undef PG8_MMA
#undef PG8_WAIT_V
#undef PG8_WAIT_L
#undef PG8_BAR
#undef PG8_SCHED
}
}

constexpr int DM = 1024, NB = 8, SEQ = 4096, DEPTH = 4, MTOK = NB * SEQ;
constexpr int DFF = 2816;
constexpr int EVEN_IN = 3232, RW_COLS = 1696, PCONV_LD = 1536, PRW_LD = 1792;
constexpr int ODD_IN = 704, PODD_LD = 768, QRANK = 384, KVRANK = 256;
constexpr int NH = 8, QKD = 192, VD = 128;
constexpr float NORM_EPS = 1e-6f, GN_EPS = 64e-5f;
constexpr int NWAVES = 8, NTHR = 512;

typedef unsigned short bf16;
typedef unsigned u32x4 __attribute__((ext_vector_type(4)));
typedef unsigned u32x2 __attribute__((ext_vector_type(2)));
typedef float f32x4 __attribute__((ext_vector_type(4)));
typedef float f32x2 __attribute__((ext_vector_type(2)));
typedef short bf16x8 __attribute__((ext_vector_type(8)));
#define LAS __attribute__((address_space(3)))

constexpr size_t MiB = 1u << 20;
constexpr size_t WS_WGU0 = 0, WS_WD0 = WS_WGU0 + (size_t)2 * DFF * DM * 2, WS_WGU1 = WS_WD0 + (size_t)DM * DFF * 2, WS_WD1 = WS_WGU1 + (size_t)2 * DFF * DM * 2;
constexpr size_t WS_WMIX = 33 * MiB;
static_assert(WS_WD1 + (size_t)DM * DFF * 2 <= WS_WMIX, "ffn weights");
constexpr size_t WS_WIN = WS_WMIX;
constexpr size_t WS_WOUT = WS_WMIX + 7 * MiB;
constexpr size_t WS_WQ = WS_WMIX + 9 * MiB;
constexpr size_t WS_WK = WS_WMIX + 11 * MiB;
constexpr size_t WS_WV = WS_WMIX + 12 * MiB;
constexpr size_t WS_CTL = 47 * MiB, CTL_BYTES = 16384;
constexpr size_t WS_H = 48 * MiB;
constexpr size_t WS_R = 112 * MiB;
constexpr size_t WS_ACT = WS_R;
constexpr size_t WS_PRW = WS_R;
constexpr size_t WS_PCONV = WS_R + 112 * MiB;
constexpr size_t WS_OPS = WS_R + 112 * MiB;
constexpr size_t WS_GBUF = WS_R + 304 * MiB;
constexpr size_t WS_SCAL = WS_R + 336 * MiB;
constexpr size_t WS_YRAW = WS_R;
constexpr size_t WS_PODD = WS_R;
constexpr size_t WS_CQN = WS_R + 48 * MiB;
constexpr size_t WS_CKVN = WS_R + 72 * MiB;
constexpr size_t WS_KF = WS_R;
constexpr size_t WS_QB = WS_R + 96 * MiB;
constexpr size_t WS_KNOPE = WS_R + 192 * MiB;
constexpr size_t WS_VT = WS_R + 256 * MiB;
constexpr size_t WS_KPE = WS_R + 320 * MiB;
constexpr size_t WS_END = WS_R + 340 * MiB;

constexpr int LDS_MISC = 131072 + 320;
constexpr int LDS_BYTES = 147456;

__device__ __forceinline__ float bf2f(bf16 b) { return __uint_as_float((unsigned)b << 16); }
__device__ __forceinline__ float bflo(unsigned w) { return __uint_as_float(w << 16); }
__device__ __forceinline__ float bfhi(unsigned w) { return __uint_as_float(w & 0xffff0000u); }
__device__ __forceinline__ unsigned pk2(float lo, float hi) { return pg8::cvt_pk_bf16(lo, hi); }
__device__ __forceinline__ bf16 f2bf(float f) { return (bf16)(pk2(f, 0.f) & 0xffffu); }
__device__ __forceinline__ float shfl_xor_l(float v, int lane, int mask) { return __int_as_float(__builtin_amdgcn_ds_bpermute((lane ^ mask) << 2, __float_as_int(v))); }
__device__ __forceinline__ void unpack8(const u32x4 w, float (&f)[8]) { f[0] = bflo(w.x); f[1] = bfhi(w.x); f[2] = bflo(w.y); f[3] = bfhi(w.y); f[4] = bflo(w.z); f[5] = bfhi(w.z); f[6] = bflo(w.w); f[7] = bfhi(w.w); }
__device__ __forceinline__ u32x4 pack8(const float (&f)[8]) { u32x4 w; w.x = pk2(f[0], f[1]); w.y = pk2(f[2], f[3]); w.z = pk2(f[4], f[5]); w.w = pk2(f[6], f[7]); return w; }
__device__ __forceinline__ int bidx() { int b = blockIdx.x; asm volatile("" : "+s"(b)); return b; }
__device__ __forceinline__ int gdimx() { int g = gridDim.x; asm volatile("" : "+s"(g)); return g; }
__device__ __forceinline__ float sigmoidf_(float x) { return 1.f / (1.f + __expf(-x)); }
template <int CTRL> __device__ __forceinline__ float dpp_f(float x) { return __int_as_float(__builtin_amdgcn_update_dpp(0, __float_as_int(x), CTRL, 0xF, 0xF, false)); }
__device__ __forceinline__ float row16_sum(float x) {
    x += dpp_f<0x128>(x); x += dpp_f<0x124>(x); x += dpp_f<0x122>(x); x += dpp_f<0x121>(x); return x;
}
__device__ __forceinline__ float wave_sum(float v) {
    v = row16_sum(v);
    const float a = __int_as_float(__builtin_amdgcn_readlane(__float_as_int(v), 0)), b = __int_as_float(__builtin_amdgcn_readlane(__float_as_int(v), 16));
    const float c = __int_as_float(__builtin_amdgcn_readlane(__float_as_int(v), 32)), d = __int_as_float(__builtin_amdgcn_readlane(__float_as_int(v), 48));
    return (a + b) + (c + d);
}

struct EpiStore {
    static constexpr bool PERM = true, AFTER_DRAIN = false, VTOK = false;
    bf16* O0; int ldc0; int ntile0; bf16* O1; int ldc1;
    __device__ __forceinline__ void operator()(const pg8::f32x4 (&acc)[2][2][4][2], const pg8::Unit& u, int wr, int wc, int fr, int fq) const {
        const int row0 = u.pm * 256 + wr * 64 + fr;
        bf16* base; int ldc, colt;
        if (u.pn < ntile0) { base = O0; ldc = ldc0; colt = u.pn * 256; } else { base = O1; ldc = ldc1; colt = (u.pn - ntile0) * 256; }
        const int col0 = colt + wc * 32 + 8 * fq;
#pragma unroll
        for (int ai = 0; ai < 2; ++ai)
#pragma unroll
            for (int m = 0; m < 4; ++m) {
                bf16* rowp = base + (size_t)(row0 + ai * 128 + m * 16) * ldc + col0;
#pragma unroll
                for (int bj = 0; bj < 2; ++bj) {
                    const pg8::f32x4 v0 = acc[ai][bj][m][0], v1 = acc[ai][bj][m][1];
                    u32x4 w; w.x = pk2(v0[0], v0[1]); w.y = pk2(v0[2], v0[3]); w.z = pk2(v1[0], v1[1]); w.w = pk2(v1[2], v1[3]);
                    *(u32x4*)(rowp + bj * 128) = w;
                }
            }
    }
};
struct EpiStoreV : EpiStore { static constexpr bool VTOK = true; };
struct EpiSwiGLU {
    static constexpr bool PERM = true, AFTER_DRAIN = false, VTOK = false;
    bf16* O; int ldc;
    __device__ __forceinline__ void operator()(const pg8::f32x4 (&acc)[2][2][4][2], const pg8::Unit& u, int wr, int wc, int fr, int fq) const {
        const int row0 = u.pm * 256 + wr * 64 + fr;
        const int col0 = u.pn * 128 + wc * 32 + 8 * fq;
#pragma unroll
        for (int ai = 0; ai < 2; ++ai)
#pragma unroll
            for (int m = 0; m < 4; ++m) {
                bf16* rowp = O + (size_t)(row0 + ai * 128 + m * 16) * ldc + col0;
                float r[8];
#pragma unroll
                for (int n = 0; n < 2; ++n)
#pragma unroll
                    for (int j = 0; j < 4; ++j) {
                        const float g = acc[ai][0][m][n][j], up = acc[ai][1][m][n][j];
                        const float s = g * __builtin_amdgcn_rcpf(1.f + __builtin_amdgcn_exp2f(-1.4426950408889634f * g));
                        r[n * 4 + j] = s * up;
                    }
                u32x4 w; w.x = pk2(r[0], r[1]); w.y = pk2(r[2], r[3]); w.z = pk2(r[4], r[5]); w.w = pk2(r[6], r[7]);
                *(u32x4*)rowp = w;
            }
    }
};
struct EpiResidual {
    static constexpr bool PERM = false, AFTER_DRAIN = false, VTOK = false;
    float* X; int ldc; float scale;
    __device__ __forceinline__ void operator()(const pg8::f32x4 (&acc)[2][2][4][2], const pg8::Unit& u, int wr, int wc, int fr, int fq) const {
        const int row0 = u.pm * 256 + wr * 64 + fr;
        const int col0 = u.pn * 256 + wc * 32 + 4 * fq;
#pragma unroll
        for (int ai = 0; ai < 2; ++ai)
#pragma unroll
            for (int m = 0; m < 4; ++m) {
                float* rowp = X + (size_t)(row0 + ai * 128 + m * 16) * ldc + col0;
#pragma unroll
                for (int bj = 0; bj < 2; ++bj)
#pragma unroll
                    for (int n = 0; n < 2; ++n) {
                        f32x4* p = (f32x4*)(rowp + bj * 128 + n * 16);
                        f32x4 v = *p; const pg8::f32x4 a = acc[ai][bj][m][n];
                        v[0] += scale * a[0]; v[1] += scale * a[1]; v[2] += scale * a[2]; v[3] += scale * a[3];
                        *p = v;
                    }
            }
    }
};

__device__ __forceinline__ void tr_item(const float* W, int ldw, int col0, int k0, bf16* WT, int K, int drow0, float* scr, int lane) {
#pragma unroll 8
    for (int i = 0; i < 32; ++i) { const int kk = 2 * i + (lane >> 5); scr[kk * 33 + (lane & 31)] = W[(size_t)(k0 + kk) * ldw + col0 + (lane & 31)]; }
    asm volatile("s_waitcnt lgkmcnt(0)" ::: "memory");
    const int c = lane & 7;
#pragma unroll
    for (int j = 0; j < 4; ++j) {
        const int n = (lane >> 3) + 8 * j; const float* s = scr + (8 * c) * 33 + n;
        u32x4 o; o.x = pk2(s[0 * 33], s[1 * 33]); o.y = pk2(s[2 * 33], s[3 * 33]); o.z = pk2(s[4 * 33], s[5 * 33]); o.w = pk2(s[6 * 33], s[7 * 33]);
        *(u32x4*)(WT + (size_t)(drow0 + n) * K + k0 + 8 * c) = o;
    }
    asm volatile("s_waitcnt lgkmcnt(0)" ::: "memory");
}

struct Params { const float* in[28]; float* out; unsigned char* ws; };
enum { I_X = 0, I_POS, I_GAINS, I_FG, I_FU, I_FD, I_EWIN, I_ECONV, I_EMU, I_W0, I_WUP, I_A0, I_AUP, I_GUP, I_KK, I_KA, I_RK, I_LNW, I_LNB, I_EWOUT,
       I_OWIN, I_QAN, I_KVAN, I_WQUP, I_WKVUP, I_QN, I_KN, I_OWOUT };

__device__ __forceinline__ void convert_layer_weights(const Params& P, int layer, float* scr, int gw, int ngw, int lane) {
    unsigned char* ws = P.ws;
    const int idx = layer >> 1; const bool even = !(layer & 1);
    constexpr int N_GU = (2 * DFF / 32) * (DM / 64);
    constexpr int N_D = (DM / 32) * (DFF / 64);
    constexpr int N_EWIN = (EVEN_IN / 32) * (DM / 64);
    constexpr int N_SQ = (DM / 32) * (DM / 64);
    constexpr int N_OWIN = (ODD_IN / 32) * (DM / 64);
    constexpr int N_WQ = (1536 / 32) * (QRANK / 64);
    constexpr int N_WKV = (1024 / 32) * (KVRANK / 64);
    const int nmix = even ? (N_EWIN + N_SQ) : (N_OWIN + N_WQ + 2 * N_WKV + N_SQ);
    const int total = 2 * (N_GU + N_D) + nmix;
    for (int it = gw; it < total; it += ngw) {
        int r = it;
        if (r < 2 * (N_GU + N_D)) {
            const int ff = r / (N_GU + N_D); r -= ff * (N_GU + N_D);
            const size_t woff = (size_t)(layer * 2 + ff) * DM * DFF;
            if (r < N_GU) {
                const int nb = r % 176, kb = r / 176, nd = 32 * nb, pn = nd >> 8, within = nd & 255, sel = within >> 7;
                const float* src = (sel ? P.in[I_FU] : P.in[I_FG]) + woff;
                tr_item(src, DFF, 128 * pn + (within & 127), 64 * kb, (bf16*)(ws + (ff ? WS_WGU1 : WS_WGU0)), DM, nd, scr, lane);
            } else {
                r -= N_GU; const int nb = r % 32, kb = r / 32;
                tr_item(P.in[I_FD] + woff, DM, 32 * nb, 64 * kb, (bf16*)(ws + (ff ? WS_WD1 : WS_WD0)), DFF, 32 * nb, scr, lane);
            }
            continue;
        }
        r -= 2 * (N_GU + N_D);
        if (even) {
            if (r < N_EWIN) { const int nb = r % 101, kb = r / 101; tr_item(P.in[I_EWIN] + (size_t)idx * DM * EVEN_IN, EVEN_IN, 32 * nb, 64 * kb, (bf16*)(ws + WS_WIN), DM, 32 * nb, scr, lane); continue; }
            r -= N_EWIN;
            { const int nb = r % 32, kb = r / 32; tr_item(P.in[I_EWOUT] + (size_t)idx * DM * DM, DM, 32 * nb, 64 * kb, (bf16*)(ws + WS_WOUT), DM, 32 * nb, scr, lane); }
        } else {
            if (r < N_OWIN) { const int nb = r % 22, kb = r / 22; tr_item(P.in[I_OWIN] + (size_t)idx * DM * ODD_IN, ODD_IN, 32 * nb, 64 * kb, (bf16*)(ws + WS_WIN), DM, 32 * nb, scr, lane); continue; }
            r -= N_OWIN;
            if (r < N_WQ) { const int nb = r % 48, kb = r / 48; tr_item(P.in[I_WQUP] + (size_t)idx * QRANK * 1536, 1536, 32 * nb, 64 * kb, (bf16*)(ws + WS_WQ), QRANK, 32 * nb, scr, lane); continue; }
            r -= N_WQ;
            if (r < 2 * N_WKV) {
                const int sel = r / N_WKV; r -= sel * N_WKV;
                const int nb = r % 32, kb = r / 32, nd = 32 * nb;
                tr_item(P.in[I_WKVUP] + (size_t)idx * KVRANK * 2048, 2048, (nd >> 7) * 256 + sel * 128 + (nd & 127), 64 * kb, (bf16*)(ws + (sel ? WS_WV : WS_WK)), KVRANK, nd, scr, lane);
                continue;
            }
            r -= 2 * N_WKV;
            { const int nb = r % 32, kb = r / 32; tr_item(P.in[I_OWOUT] + (size_t)idx * DM * DM, DM, 32 * nb, 64 * kb, (bf16*)(ws + WS_WOUT), DM, 32 * nb, scr, lane); }
        }
    }
}

__device__ __forceinline__ void rms_phase(const float* src, float* cpy, const float* gain, bf16* dst, int gw, int ngw, int lane) {
    f32x4 g[4];
#pragma unroll
    for (int j = 0; j < 4; ++j) g[j] = ((const f32x4*)gain)[lane + 64 * j];
    for (int m = 2 * gw; m < MTOK; m += 2 * ngw) {
        f32x4 v[2][4]; float s[2] = {0.f, 0.f};
#pragma unroll
        for (int u = 0; u < 2; ++u) { const f32x4* xr = (const f32x4*)(src + (size_t)(m + u) * DM) + lane;
#pragma unroll
            for (int j = 0; j < 4; ++j) v[u][j] = xr[64 * j]; }
#pragma unroll
        for (int u = 0; u < 2; ++u) {
#pragma unroll
            for (int j = 0; j < 4; ++j) s[u] += (v[u][j].x * v[u][j].x + v[u][j].y * v[u][j].y) + (v[u][j].z * v[u][j].z + v[u][j].w * v[u][j].w);
            if (cpy) { f32x4* cr = (f32x4*)(cpy + (size_t)(m + u) * DM) + lane;
#pragma unroll
                for (int j = 0; j < 4; ++j) cr[64 * j] = v[u][j]; }
        }
#pragma unroll
        for (int u = 0; u < 2; ++u) {
            const float rstd = rsqrtf(wave_sum(s[u]) * (1.f / DM) + NORM_EPS);
            u32x2* o8 = (u32x2*)(dst + (size_t)(m + u) * DM) + lane;
#pragma unroll
            for (int j = 0; j < 4; ++j) { u32x2 o; o.x = pk2(v[u][j].x * rstd * g[j].x, v[u][j].y * rstd * g[j].y); o.y = pk2(v[u][j].z * rstd * g[j].z, v[u][j].w * rstd * g[j].w); o8[64 * j] = o; }
        }
    }
}

__device__ __forceinline__ void conv_phase(const bf16* pconv, const float* cw, bf16* ycat, int gtid, int nthr) {
#pragma unroll 2
    for (int item = gtid; item < MTOK * 64; item += nthr) {
        const int m = item >> 6, c8 = (item & 63) * 8, t = m & (SEQ - 1);
        const bf16* row = pconv + (size_t)m * PCONV_LD;
        const u32x4 gb = *(const u32x4*)(row + c8), gc0 = *(const u32x4*)(row + 512 + c8), hi0 = *(const u32x4*)(row + 1024 + c8);
        const bf16* row1 = t >= 1 ? row - PCONV_LD : row; const bf16* row2 = t >= 2 ? row - 2 * PCONV_LD : row;
        u32x4 gc1 = *(const u32x4*)(row1 + 512 + c8), hi1 = *(const u32x4*)(row1 + 1024 + c8), gc2 = *(const u32x4*)(row2 + 512 + c8), hi2 = *(const u32x4*)(row2 + 1024 + c8);
        const unsigned k1 = t >= 1 ? 0xffffffffu : 0u, k2 = t >= 2 ? 0xffffffffu : 0u;
        gc1.x &= k1; gc1.y &= k1; gc1.z &= k1; gc1.w &= k1; gc2.x &= k2; gc2.y &= k2; gc2.z &= k2; gc2.w &= k2;
        float y[8];
#pragma unroll
        for (int e = 0; e < 4; ++e) {
            const float w0a = cw[c8 + 2 * e], w0b = cw[c8 + 2 * e + 1], w1a = cw[512 + c8 + 2 * e], w1b = cw[512 + c8 + 2 * e + 1], w2a = cw[1024 + c8 + 2 * e], w2b = cw[1024 + c8 + 2 * e + 1];
            const float u0a = bflo(gc0[e]) * bflo(hi0[e]), u0b = bfhi(gc0[e]) * bfhi(hi0[e]);
            const float u1a = bflo(gc1[e]) * bflo(hi1[e]), u1b = bfhi(gc1[e]) * bfhi(hi1[e]);
            const float u2a = bflo(gc2[e]) * bflo(hi2[e]), u2b = bfhi(gc2[e]) * bfhi(hi2[e]);
            y[2 * e] = bflo(gb[e]) * (w0a * u2a + w1a * u1a + w2a * u0a);
            y[2 * e + 1] = bfhi(gb[e]) * (w0b * u2b + w1b * u1b + w2b * u0b);
        }
        u32x4 o; o.x = pk2(y[0], y[1]); o.y = pk2(y[2], y[3]); o.z = pk2(y[4], y[5]); o.w = pk2(y[6], y[7]);
        *(u32x4*)(ycat + (size_t)m * DM + c8) = o;
    }
}

constexpr int PP_LIN_LD = 168;
constexpr int PP_CST = 8192, PP_GFR = 32768;
__device__ __forceinline__ float fast_sigmoid(float x) { return __builtin_amdgcn_rcpf(1.f + __expf(-x)); }
template <bool STORE> __device__ __forceinline__ void prep_phase(const Params& P, int idx, unsigned char* lds, int tid, int wave, int lane) {
    const int BIDX = bidx(), GDIMX = gdimx();
    const bf16* prw = (const bf16*)(P.ws + WS_PRW);
    bf16* ops = (bf16*)(P.ws + WS_OPS); bf16* gbuf = (bf16*)(P.ws + WS_GBUF); float* scal = (float*)(P.ws + WS_SCAL);
    const float* mu = P.in[I_EMU] + (size_t)idx * RW_COLS;
    const int fr = lane & 15, g = lane >> 4, h = wave;
    bf16* lin = (bf16*)lds; float* cst = (float*)(lds + PP_CST);
    cst[0 * 512 + tid] = P.in[I_W0][idx * 512 + tid]; cst[1 * 512 + tid] = P.in[I_A0][idx * 512 + tid]; cst[2 * 512 + tid] = P.in[I_KK][idx * 512 + tid]; cst[3 * 512 + tid] = P.in[I_KA][idx * 512 + tid];
    cst[4 * 512 + tid] = P.in[I_RK][idx * 512 + tid]; cst[5 * 512 + tid] = mu[tid]; cst[6 * 512 + tid] = mu[512 + tid]; cst[7 * 512 + tid] = mu[1024 + tid];
    bf16x8 wfr[4], afr[4];
    const float* wup = P.in[I_WUP] + (size_t)idx * 32 * 512; const float* aup = P.in[I_AUP] + (size_t)idx * 32 * 512; const float* gup = P.in[I_GUP] + (size_t)idx * 96 * 512;
#pragma unroll
    for (int nb = 0; nb < 4; ++nb) {
        const int col = 64 * h + 16 * nb + fr;
        u32x4 ww, aa;
        ww.x = pk2(wup[(8 * g + 0) * 512 + col], wup[(8 * g + 1) * 512 + col]); ww.y = pk2(wup[(8 * g + 2) * 512 + col], wup[(8 * g + 3) * 512 + col]);
        ww.z = pk2(wup[(8 * g + 4) * 512 + col], wup[(8 * g + 5) * 512 + col]); ww.w = pk2(wup[(8 * g + 6) * 512 + col], wup[(8 * g + 7) * 512 + col]);
        aa.x = pk2(aup[(8 * g + 0) * 512 + col], aup[(8 * g + 1) * 512 + col]); aa.y = pk2(aup[(8 * g + 2) * 512 + col], aup[(8 * g + 3) * 512 + col]);
        aa.z = pk2(aup[(8 * g + 4) * 512 + col], aup[(8 * g + 5) * 512 + col]); aa.w = pk2(aup[(8 * g + 6) * 512 + col], aup[(8 * g + 7) * 512 + col]);
        wfr[nb] = __builtin_bit_cast(bf16x8, ww); afr[nb] = __builtin_bit_cast(bf16x8, aa);
#pragma unroll
        for (int ks = 0; ks < 3; ++ks) {
            const int kb = 32 * ks + 8 * g; u32x4 gg_;
            gg_.x = pk2(gup[(kb + 0) * 512 + col], gup[(kb + 1) * 512 + col]); gg_.y = pk2(gup[(kb + 2) * 512 + col], gup[(kb + 3) * 512 + col]);
            gg_.z = pk2(gup[(kb + 4) * 512 + col], gup[(kb + 5) * 512 + col]); gg_.w = pk2(gup[(kb + 6) * 512 + col], gup[(kb + 7) * 512 + col]);
            *(u32x4*)(lds + PP_GFR + ((((h * 3 + ks) * 4 + nb) * 64 + lane) * 16)) = gg_;
        }
    }
    __syncthreads();
    for (int tile = BIDX; tile < MTOK / 16; tile += GDIMX) {
        const int m0 = tile * 16;
        if (tid < 320) {
            const int tok = tid / 20, ch = tid - tok * 20, m = m0 + tok, t = m & (SEQ - 1);
            const u32x4 wc = *(const u32x4*)(prw + (size_t)m * PRW_LD + 1536 + 8 * ch);
            const u32x4 wp = *(const u32x4*)(prw + (size_t)(t ? m - 1 : m) * PRW_LD + 1536 + 8 * ch);
            const f32x4 mu0 = *(const f32x4*)(mu + 1536 + 8 * ch), mu1 = *(const f32x4*)(mu + 1536 + 8 * ch + 4);
            float cur[8], prv[8], f[8]; unpack8(wc, cur); unpack8(wp, prv);
            const float mus[8] = {mu0.x, mu0.y, mu0.z, mu0.w, mu1.x, mu1.y, mu1.z, mu1.w};
#pragma unroll
            for (int e = 0; e < 8; ++e) {
                const float pv = t ? prv[e] : 0.f;
                const float x = cur[e] + (pv - cur[e]) * mus[e];
                const float th = 1.f - 2.f * __builtin_amdgcn_rcpf(1.f + __expf(2.f * x)), sg = fast_sigmoid(x);
                f[e] = ch < 4 ? th : (ch < 8 ? x : sg);
            }
            *(u32x4*)(lin + tok * PP_LIN_LD + 8 * ch) = pack8(f);
        }
        __syncthreads();
        const int m = m0 + fr, t = m & (SEQ - 1), b = m >> 12;
        const bf16* row = prw + (size_t)m * PRW_LD + 64 * h + 4 * g;
        u32x2 rc[4], kc[4], vc[4], rp[4], kp[4], vp[4];
#pragma unroll
        for (int nb = 0; nb < 4; ++nb) { rc[nb] = *(const u32x2*)(row + 16 * nb); kc[nb] = *(const u32x2*)(row + 512 + 16 * nb); vc[nb] = *(const u32x2*)(row + 1024 + 16 * nb); }
        {   const bf16* prow = t ? row - PRW_LD : row; const unsigned keep = t ? 0xffffffffu : 0u;
#pragma unroll
            for (int nb = 0; nb < 4; ++nb) { rp[nb] = *(const u32x2*)(prow + 16 * nb); kp[nb] = *(const u32x2*)(prow + 512 + 16 * nb); vp[nb] = *(const u32x2*)(prow + 1024 + 16 * nb);
                rp[nb].x &= keep; rp[nb].y &= keep; kp[nb].x &= keep; kp[nb].y &= keep; vp[nb].x &= keep; vp[nb].y &= keep; }
        }
        bf16x8 bfr[5];
#pragma unroll
        for (int ks = 0; ks < 5; ++ks) bfr[ks] = *(const bf16x8*)(lin + fr * PP_LIN_LD + 32 * ks + 8 * g);
        float ss = 0.f;
#pragma unroll
        for (int nb = 0; nb < 4; ++nb) {
            const int cb = 64 * h + 16 * nb + 4 * g;
            const f32x4 muk = *(const f32x4*)(cst + 6 * 512 + cb), kkc = *(const f32x4*)(cst + 2 * 512 + cb);
            const float c0 = bflo(kc[nb].x), c1 = bfhi(kc[nb].x), c2 = bflo(kc[nb].y), c3 = bfhi(kc[nb].y);
            const float p0 = bflo(kp[nb].x), p1 = bfhi(kp[nb].x), p2 = bflo(kp[nb].y), p3 = bfhi(kp[nb].y);
            const float q0 = (c0 + (p0 - c0) * muk.x) * kkc.x, q1 = (c1 + (p1 - c1) * muk.y) * kkc.y, q2 = (c2 + (p2 - c2) * muk.z) * kkc.z, q3 = (c3 + (p3 - c3) * muk.w) * kkc.w;
            ss += (q0 * q0 + q1 * q1) + (q2 * q2 + q3 * q3);
        }
        ss += shfl_xor_l(ss, lane, 16); ss += shfl_xor_l(ss, lane, 32);
        const float kinv = rsqrtf(fmaxf(ss, 1e-24f));
        float br = 0.f, kr = 0.f, rk = 0.f;
        bf16* op = ops + ((size_t)(b * NH + h) * (SEQ / 16) + (t >> 4)) * 6144 + lane * 4;
        bf16* gp = gbuf + ((size_t)tile * NH + h) * 1024 + lane * 4;
#pragma unroll
        for (int nb = 0; nb < 4; ++nb) {
            const int cb = 64 * h + 16 * nb + 4 * g;
            const f32x4 w0c = *(const f32x4*)(cst + 0 * 512 + cb), a0c = *(const f32x4*)(cst + 1 * 512 + cb), kkc = *(const f32x4*)(cst + 2 * 512 + cb), kac = *(const f32x4*)(cst + 3 * 512 + cb);
            const f32x4 rkc = *(const f32x4*)(cst + 4 * 512 + cb), mur = *(const f32x4*)(cst + 5 * 512 + cb), muv = *(const f32x4*)(cst + 7 * 512 + cb);
            const f32x4 muk = *(const f32x4*)(cst + 6 * 512 + cb);
            const pg8::f32x4 z0 = {0.f, 0.f, 0.f, 0.f};
            const pg8::f32x4 zw = __builtin_amdgcn_mfma_f32_16x16x32_bf16(wfr[nb], bfr[0], z0, 0, 0, 0);
            const pg8::f32x4 za = __builtin_amdgcn_mfma_f32_16x16x32_bf16(afr[nb], bfr[1], z0, 0, 0, 0);
            pg8::f32x4 gg = z0;
#pragma unroll
            for (int ks = 0; ks < 3; ++ks) gg = __builtin_amdgcn_mfma_f32_16x16x32_bf16(*(const bf16x8*)(lds + PP_GFR + ((((h * 3 + ks) * 4 + nb) * 64 + lane) * 16)), bfr[2 + ks], gg, 0, 0, 0);
            float o_um[4], o_wr[4], o_a[4], o_b[4], o_k[4], o_v[4], o_g[4];
#pragma unroll
            for (int r4 = 0; r4 < 4; ++r4) {
                const unsigned rcw = r4 < 2 ? rc[nb].x : rc[nb].y, rpw = r4 < 2 ? rp[nb].x : rp[nb].y, vcw = r4 < 2 ? vc[nb].x : vc[nb].y, vpw = r4 < 2 ? vp[nb].x : vp[nb].y;
                const unsigned kcw = r4 < 2 ? kc[nb].x : kc[nb].y, kpw = r4 < 2 ? kp[nb].x : kp[nb].y;
                const float kcur = (r4 & 1) ? bfhi(kcw) : bflo(kcw), kprev = (r4 & 1) ? bfhi(kpw) : bflo(kpw);
                const float rcur = (r4 & 1) ? bfhi(rcw) : bflo(rcw), rprev = (r4 & 1) ? bfhi(rpw) : bflo(rpw), vcur = (r4 & 1) ? bfhi(vcw) : bflo(vcw), vprev = (r4 & 1) ? bfhi(vpw) : bflo(vpw);
                const float r = rcur + (rprev - rcur) * mur[r4], v = vcur + (vprev - vcur) * muv[r4], k = kcur + (kprev - kcur) * muk[r4];
                const float nz = -(w0c[r4] + zw[r4]);
                const float sp = fmaxf(nz, 0.f) + __logf(1.f + __expf(-fabsf(nz)));
                const float e = __expf(-sp - 0.5f);
                const float wdec = __expf(-e), um = 1.f - wdec;
                const float iclr = fast_sigmoid(a0c[r4] + za[r4]);
                const float kk = k * kkc[r4] * kinv;
                const float kh = k * (1.f + (iclr - 1.f) * kac[r4]);
                const float bv = kk * iclr;
                br += bv * r; kr += kh * r; rk += r * kh * rkc[r4];
                o_um[r4] = um; o_wr[r4] = wdec * r; o_a[r4] = -kk; o_b[r4] = bv; o_k[r4] = kh; o_v[r4] = v; o_g[r4] = gg[r4];
            }
            u32x2 w2; if (STORE) {
            w2.x = pk2(o_um[0], o_um[1]); w2.y = pk2(o_um[2], o_um[3]); *(u32x2*)(op + (0 + nb) * 256) = w2;
            w2.x = pk2(o_wr[0], o_wr[1]); w2.y = pk2(o_wr[2], o_wr[3]); *(u32x2*)(op + (4 + nb) * 256) = w2;
            w2.x = pk2(o_a[0], o_a[1]); w2.y = pk2(o_a[2], o_a[3]); *(u32x2*)(op + (8 + nb) * 256) = w2;
            w2.x = pk2(o_b[0], o_b[1]); w2.y = pk2(o_b[2], o_b[3]); *(u32x2*)(op + (12 + nb) * 256) = w2;
            w2.x = pk2(o_k[0], o_k[1]); w2.y = pk2(o_k[2], o_k[3]); *(u32x2*)(op + (16 + nb) * 256) = w2;
            w2.x = pk2(o_v[0], o_v[1]); w2.y = pk2(o_v[2], o_v[3]); *(u32x2*)(op + (20 + nb) * 256) = w2;
            w2.x = pk2(o_g[0], o_g[1]); w2.y = pk2(o_g[2], o_g[3]); *(u32x2*)(gp + nb * 256) = w2; }
            else { asm volatile("" :: "v"(o_um[0] + o_wr[1] + o_a[2] + o_b[3] + o_k[0] + o_v[1] + o_g[2])); }
        }
        br += shfl_xor_l(br, lane, 16); br += shfl_xor_l(br, lane, 32);
        kr += shfl_xor_l(kr, lane, 16); kr += shfl_xor_l(kr, lane, 32);
        rk += shfl_xor_l(rk, lane, 16); rk += shfl_xor_l(rk, lane, 32);
        if (!STORE) { asm volatile("" :: "v"(br + kr + rk)); } else if (g == 0) { f32x4 s4 = {br, kr, rk, 0.f}; *(f32x4*)(scal + ((size_t)(b * NH + h) * SEQ + t) * 4) = s4; }
        __syncthreads();
    }
}

constexpr int SC_TC = 32, SC_STEP = 340, SC_BUF = SC_TC * SC_STEP;
struct StepOps { f32x4 W, AW0, AW1, B, K; float v; f32x2 sc; };
__device__ __forceinline__ void sc_load(StepOps& o, const float* p, int wq, int row16) {
    o.W = *(const f32x4*)(p + wq); o.AW0 = *(const f32x4*)(p + 64 + wq); o.AW1 = *(const f32x4*)(p + 128 + wq); o.B = *(const f32x4*)(p + 192 + wq); o.K = *(const f32x4*)(p + 256 + wq);
    o.v = p[320 + row16]; o.sc = *(const f32x2*)(p + 336);
}
__device__ __forceinline__ void scan_phase(const Params& P, float* lds, int tid, int wave, int lane) {
    const int BIDX = bidx(), GDIMX = gdimx();
    const bf16* ops = (const bf16*)(P.ws + WS_OPS); const float* scal = (const float*)(P.ws + WS_SCAL); float* yraw = (float*)(P.ws + WS_YRAW);
    float* buf0 = lds; float* ybuf0 = lds + 2 * SC_BUF;
    const int vcu = (GDIMX % 8 == 0) ? (BIDX % 8) * (GDIMX / 8) + BIDX / 8 : BIDX;
    for (int unit = vcu; unit < 256; unit += GDIMX) {
        const int bh = unit >> 2, rq = unit & 3, b = bh >> 3, hh = bh & 7;
        const bool loader = wave >= 4; const int ltid = tid - 256;
        const int ks = lane & 15, row16 = (wave & 3) * 4 + (lane >> 4), wq = 4 * ks;
        float s0 = 0.f, s1 = 0.f, s2 = 0.f, s3 = 0.f;
        const int ydelta = row16 * 8 + (ks & 7);
        u32x4 ld_[6]; f32x4 sc4_ = {0.f, 0.f, 0.f, 0.f};
#define SC_LOAD(c) do { const int t0_ = (c) * SC_TC; const bf16* src_ = ops + ((size_t)bh * (SEQ / 16) + (t0_ >> 4)) * 6144; \
            _Pragma("unroll") for (int i = 0; i < 6; ++i) ld_[i] = *(const u32x4*)(src_ + (size_t)(ltid + 256 * i) * 8); \
            if (ltid < 32) sc4_ = *(const f32x4*)(scal + ((size_t)bh * SEQ + t0_ + ltid) * 4); } while (0)
#define SC_WRITE(c) do { float* bufw = buf0 + ((c) & 1) * SC_BUF; \
            _Pragma("unroll") for (int i = 0; i < 6; ++i) { const int id = ltid + 256 * i, tl = id / 768, rem = id - tl * 768, vec = rem >> 7, r2 = rem & 127, nb = r2 >> 5, lp = r2 & 31; \
                const int tk = tl * 16 + ((2 * lp) & 15), gq = (2 * lp) >> 4;        \
                f32x4 lo_ = {bflo(ld_[i].x), bfhi(ld_[i].x), bflo(ld_[i].y), bfhi(ld_[i].y)}, hi_ = {bflo(ld_[i].z), bfhi(ld_[i].z), bflo(ld_[i].w), bfhi(ld_[i].w)}; \
                if (vec == 0) { lo_ = 1.f - lo_; hi_ = 1.f - hi_; } \
                if (vec == 1 || vec == 2) { float* d_ = bufw + tk * SC_STEP + 64 + 4 * (4 * nb + gq) + (vec == 1 ? 1 : 0);        \
                    d_[0] = lo_.x; d_[2] = lo_.y; d_[64] = lo_.z; d_[66] = lo_.w; d_ += SC_STEP; d_[0] = hi_.x; d_[2] = hi_.y; d_[64] = hi_.z; d_[66] = hi_.w; } \
                else if (vec < 5) { float* d_ = bufw + tk * SC_STEP + vec * 64 + 16 * nb + 4 * gq; *(f32x4*)d_ = lo_; *(f32x4*)(d_ + SC_STEP) = hi_; } \
                else if (nb == rq) { float* d_ = bufw + tk * SC_STEP + 320 + 4 * gq; *(f32x4*)d_ = lo_; *(f32x4*)(d_ + SC_STEP) = hi_; } } \
            if (ltid < 32) { f32x2 s2_ = {sc4_.x * 0.125f, sc4_.y * 0.125f}; *(f32x2*)(bufw + ltid * SC_STEP + 336) = s2_; } } while (0)
#define SC_YOUT(c) do { const float* yb_ = ybuf0 + ((c) & 1) * (SC_TC * 128); const int t0_ = (c) * SC_TC; \
            _Pragma("unroll") for (int i = 0; i < 2; ++i) { const int id = ltid + 256 * i; \
                const f32x4 pa_ = *(const f32x4*)(yb_ + id * 8), pb_ = *(const f32x4*)(yb_ + id * 8 + 4);        \
                yraw[((size_t)(bh * 4 + rq) * SEQ + t0_) * 16 + id] = ((pa_.x + pa_.y) + (pa_.z + pa_.w)) + ((pb_.x + pb_.y) + (pb_.z + pb_.w)); } } while (0)
        constexpr int NCH = SEQ / SC_TC;
        if (loader) { SC_LOAD(0); SC_WRITE(0); SC_LOAD(1); }
        __syncthreads();
        for (int c = 0; c < NCH; ++c) {
            if (loader) {
                if (c + 1 < NCH) SC_WRITE(c + 1);
                if (c + 2 < NCH) SC_LOAD(c + 2);
                if (c > 0) SC_YOUT(c - 1);
            } else {
                __builtin_amdgcn_s_setprio(1);
                const float* bufr = buf0 + (c & 1) * SC_BUF; float* ybl = ybuf0 + (c & 1) * (SC_TC * 128) + ydelta;
                StepOps cur, nxt;
                sc_load(cur, bufr, wq, row16);
#pragma unroll 4
                for (int st = 0; st < SC_TC; ++st) {
                    sc_load(nxt, bufr + (st + 1 < SC_TC ? st + 1 : st) * SC_STEP, wq, row16);
                    f32x2 dd = (f32x2){cur.AW0.x, cur.AW0.y} * s0;
                    dd += (f32x2){cur.AW0.z, cur.AW0.w} * s1; dd += (f32x2){cur.AW1.x, cur.AW1.y} * s2; dd += (f32x2){cur.AW1.z, cur.AW1.w} * s3;
                    float da = dd.x, dy = dd.y;
                    da = row16_sum(da); dy += dpp_f<0x128>(dy);
                    s0 = s0 * cur.W.x + da * cur.B.x + cur.v * cur.K.x;
                    s1 = s1 * cur.W.y + da * cur.B.y + cur.v * cur.K.y;
                    s2 = s2 * cur.W.z + da * cur.B.z + cur.v * cur.K.z;
                    s3 = s3 * cur.W.w + da * cur.B.w + cur.v * cur.K.w;
                    const float y = dy + da * cur.sc.x + cur.v * cur.sc.y;
                    ybl[st * 128] = y;
                    cur = nxt;
                }
                __builtin_amdgcn_s_setprio(0);
            }
            __syncthreads();
        }
        if (loader) SC_YOUT(NCH - 1);
        __syncthreads();
#undef SC_LOAD
#undef SC_WRITE
#undef SC_YOUT
    }
}

__device__ __forceinline__ void post_phase(const Params& P, int idx, unsigned char* lds, int gw, int ngw, int wave, int lane) {
    const float* yraw = (const float*)(P.ws + WS_YRAW); const bf16* ops = (const bf16*)(P.ws + WS_OPS); const float* scal = (const float*)(P.ws + WS_SCAL);
    const bf16* gbuf = (const bf16*)(P.ws + WS_GBUF); bf16* ycat = (bf16*)(P.ws + WS_H);
    const int fr = lane & 15, g = lane >> 4;
    unsigned char* stg = lds + wave * 2304;
    for (int task = gw; task < (MTOK / 16) * NH; task += ngw) {
        const int tile = task >> 3, h = task & 7, m = tile * 16 + fr, t = m & (SEQ - 1), b = m >> 12, bh = b * NH + h;
        f32x4 y[4], lw[4], lb[4]; u32x2 vv[4], gg[4];
#pragma unroll
        for (int nb = 0; nb < 4; ++nb) {
            y[nb] = *(const f32x4*)(yraw + ((size_t)(bh * 4 + nb) * SEQ + t) * 16 + 4 * g);
            vv[nb] = *(const u32x2*)(ops + ((size_t)bh * (SEQ / 16) + (t >> 4)) * 6144 + (20 + nb) * 256 + lane * 4);
            gg[nb] = *(const u32x2*)(gbuf + ((size_t)tile * NH + h) * 1024 + nb * 256 + lane * 4);
            lw[nb] = *(const f32x4*)(P.in[I_LNW] + idx * 512 + h * 64 + 16 * nb + 4 * g);
            lb[nb] = *(const f32x4*)(P.in[I_LNB] + idx * 512 + h * 64 + 16 * nb + 4 * g);
        }
        const float rk = scal[((size_t)bh * SEQ + t) * 4 + 2];
        float sm = 0.f;
#pragma unroll
        for (int nb = 0; nb < 4; ++nb) sm += (y[nb].x + y[nb].y) + (y[nb].z + y[nb].w);
        sm += shfl_xor_l(sm, lane, 16); sm += shfl_xor_l(sm, lane, 32);
        const float mean = sm * (1.f / 64.f);
        float sv = 0.f;
#pragma unroll
        for (int nb = 0; nb < 4; ++nb) { y[nb] = y[nb] - mean; sv += (y[nb].x * y[nb].x + y[nb].y * y[nb].y) + (y[nb].z * y[nb].z + y[nb].w * y[nb].w); }
        sv += shfl_xor_l(sv, lane, 16); sv += shfl_xor_l(sv, lane, 32);
        const float rstd = rsqrtf(sv * (1.f / 64.f) + GN_EPS);
#pragma unroll
        for (int nb = 0; nb < 4; ++nb) {
            const float v0 = bflo(vv[nb].x), v1 = bfhi(vv[nb].x), v2 = bflo(vv[nb].y), v3 = bfhi(vv[nb].y);
            const float g0 = bflo(gg[nb].x), g1 = bfhi(gg[nb].x), g2 = bflo(gg[nb].y), g3 = bfhi(gg[nb].y);
            const float o0 = (y[nb].x * rstd * lw[nb].x + lb[nb].x + rk * v0) * g0, o1 = (y[nb].y * rstd * lw[nb].y + lb[nb].y + rk * v1) * g1;
            const float o2 = (y[nb].z * rstd * lw[nb].z + lb[nb].z + rk * v2) * g2, o3 = (y[nb].w * rstd * lw[nb].w + lb[nb].w + rk * v3) * g3;
            u32x2 w; w.x = pk2(o0, o1); w.y = pk2(o2, o3);
            *(u32x2*)(stg + fr * 144 + (16 * nb + 4 * g) * 2) = w;
        }
        asm volatile("s_waitcnt lgkmcnt(0)" ::: "memory");
#pragma unroll
        for (int i = 0; i < 2; ++i) { const int rowi = 8 * i + (lane >> 3), ch = lane & 7;
            const u32x4 w = *(const u32x4*)(stg + rowi * 144 + ch * 16);
            *(u32x4*)(ycat + (size_t)(tile * 16 + rowi) * DM + 512 + h * 64 + ch * 8) = w; }
        asm volatile("s_waitcnt lgkmcnt(0)" ::: "memory");
    }
}

__device__ __forceinline__ void mla_norm_phase(const Params& P, int idx, int gw, int ngw, int lane) {
    const bf16* podd = (const bf16*)(P.ws + WS_PODD); bf16* cqn = (bf16*)(P.ws + WS_CQN); bf16* ckvn = (bf16*)(P.ws + WS_CKVN); bf16* kpe = (bf16*)(P.ws + WS_KPE);
    float gq[8], gk[8];
    const int lq = lane < 48 ? lane : 0, lk = lane < 32 ? lane : 0, lp = lane < 8 ? lane : 0;
#pragma unroll
    for (int e = 0; e < 8; ++e) { gq[e] = P.in[I_QAN][idx * QRANK + 8 * lq + e]; gk[e] = P.in[I_KVAN][idx * KVRANK + 8 * lk + e]; }
    for (int m0 = 2 * gw; m0 < MTOK; m0 += 2 * ngw) {
        u32x4 wq[2], wk[2], wp[2];
#pragma unroll
        for (int u = 0; u < 2; ++u) { const bf16* row = podd + (size_t)(m0 + u) * PODD_LD;
            wq[u] = *(const u32x4*)(row + 8 * lq); wk[u] = *(const u32x4*)(row + QRANK + 8 * lk); wp[u] = *(const u32x4*)(row + QRANK + KVRANK + 8 * lp); }
#pragma unroll
        for (int u = 0; u < 2; ++u) { const int m = m0 + u;
            float q[8], k[8]; unpack8(wq[u], q); unpack8(wk[u], k);
            float sq = 0.f, sk = 0.f;
#pragma unroll
            for (int e = 0; e < 8; ++e) { sq += q[e] * q[e]; sk += k[e] * k[e]; }
            sq = lane < 48 ? sq : 0.f; sk = lane < 32 ? sk : 0.f;
            const float rq = rsqrtf(wave_sum(sq) * (1.f / QRANK) + NORM_EPS), rk = rsqrtf(wave_sum(sk) * (1.f / KVRANK) + NORM_EPS);
#pragma unroll
            for (int e = 0; e < 8; ++e) { q[e] *= rq * gq[e]; k[e] *= rk * gk[e]; }
            if (lane < 48) *(u32x4*)(cqn + (size_t)m * QRANK + 8 * lane) = pack8(q);
            if (lane < 32) *(u32x4*)(ckvn + (size_t)m * KVRANK + 8 * lane) = pack8(k);
            if (lane < 8) *(u32x4*)(kpe + (size_t)m * 64 + 8 * lane) = wp[u]; }
    }
}

constexpr float ATTN_C2 = 0.07216878364870322f * 1.4426950408889634f;
__device__ __forceinline__ void qk_prep_phase(const Params& P, int idx, unsigned char* lds, int gw, int ngw, int wave, int lane) {
    bf16* qb = (bf16*)(P.ws + WS_QB); const bf16* knope = (const bf16*)(P.ws + WS_KNOPE); const bf16* kpe = (const bf16*)(P.ws + WS_KPE); bf16* kf = (bf16*)(P.ws + WS_KF);
    const int* pos = (const int*)P.in[I_POS];
    const int h = lane >> 3, s = lane & 7;
    float qg[24], kg[24];
#pragma unroll
    for (int e = 0; e < 16; ++e) { qg[e] = P.in[I_QN][idx * QKD + 16 * s + e]; kg[e] = P.in[I_KN][idx * QKD + 16 * s + e]; }
#pragma unroll
    for (int e = 0; e < 8; ++e) { qg[16 + e] = P.in[I_QN][idx * QKD + 128 + 8 * s + e]; kg[16 + e] = P.in[I_KN][idx * QKD + 128 + 8 * s + e]; }
    float* cst = (float*)(lds + wave * 256);
    const float inv_freq = powf(10000.f, -(float)(lane & 31) * (1.f / 32.f));
    const float sgn = s < 4 ? -1.f : 1.f;
    for (int m = gw; m < MTOK; m += ngw) {
        bf16* qrow = qb + (size_t)m * 1536 + h * QKD; const bf16* krow = knope + (size_t)m * 1024 + h * 128;
        const u32x4 qa = *(const u32x4*)(qrow + 16 * s), qc = *(const u32x4*)(qrow + 16 * s + 8), qr = *(const u32x4*)(qrow + 128 + 8 * s);
        const u32x4 ka = *(const u32x4*)(krow + 16 * s), kc = *(const u32x4*)(krow + 16 * s + 8), kr = *(const u32x4*)(kpe + (size_t)m * 64 + 8 * s);
        {
            const float ang = (float)pos[m] * inv_freq;
            const float n = rintf(ang * 0.15915494309189535f);
            float rr = fmaf(-n, 6.28318548202514648f, ang); rr = fmaf(-n, -1.7484555e-7f, rr);
            if (lane < 32) { cst[lane] = __cosf(rr); cst[32 + lane] = __sinf(rr); }
        }
        asm volatile("s_waitcnt lgkmcnt(0)" ::: "memory");
        float cs[8], sn[8];
        { const f32x4 c0 = *(const f32x4*)(cst + 8 * (s & 3)), c1 = *(const f32x4*)(cst + 8 * (s & 3) + 4), s0 = *(const f32x4*)(cst + 32 + 8 * (s & 3)), s1 = *(const f32x4*)(cst + 32 + 8 * (s & 3) + 4);
          cs[0] = c0.x; cs[1] = c0.y; cs[2] = c0.z; cs[3] = c0.w; cs[4] = c1.x; cs[5] = c1.y; cs[6] = c1.z; cs[7] = c1.w;
          sn[0] = s0.x; sn[1] = s0.y; sn[2] = s0.z; sn[3] = s0.w; sn[4] = s1.x; sn[5] = s1.y; sn[6] = s1.z; sn[7] = s1.w; }
#pragma unroll
        for (int which = 0; which < 2; ++which) {
            float x0[8], x1[8], xr[8];
            unpack8(which ? ka : qa, x0); unpack8(which ? kc : qc, x1); unpack8(which ? kr : qr, xr);
            float ss = 0.f;
#pragma unroll
            for (int e = 0; e < 8; ++e) ss += x0[e] * x0[e] + x1[e] * x1[e] + xr[e] * xr[e];
            ss += shfl_xor_l(ss, lane, 1); ss += shfl_xor_l(ss, lane, 2); ss += shfl_xor_l(ss, lane, 4);
            const float rn = rsqrtf(ss * (1.f / QKD) + NORM_EPS) * (which ? 1.f : ATTN_C2);
            float o0[8], o1[8], orr[8];
#pragma unroll
            for (int e = 0; e < 8; ++e) {
                const float g0 = which ? kg[e] : qg[e], g1 = which ? kg[8 + e] : qg[8 + e], g2 = which ? kg[16 + e] : qg[16 + e];
                o0[e] = x0[e] * rn * g0; o1[e] = x1[e] * rn * g1;
                const float val = xr[e] * rn * g2;
                const float par = shfl_xor_l(val, lane, 4);
                orr[e] = val * cs[e] + sgn * par * sn[e];
            }
            bf16* orow = which ? kf + (size_t)m * 1536 + h * QKD : qrow;
            *(u32x4*)(orow + 16 * s) = pack8(o0); *(u32x4*)(orow + 16 * s + 8) = pack8(o1); *(u32x4*)(orow + 128 + 8 * s) = pack8(orr);
        }
    }
}

constexpr int AT_KB = 64 * QKD * 2, AT_VB = VD * 64 * 2;
__device__ __forceinline__ void attn_phase(const Params& P, unsigned char* lds, int tid, int wave, int lane) {
    const int BIDX = bidx(), GDIMX = gdimx();
    const bf16* Q = (const bf16*)(P.ws + WS_QB); const bf16* Kf = (const bf16*)(P.ws + WS_KF); const bf16* VT = (const bf16*)(P.ws + WS_VT); bf16* O = (bf16*)(P.ws + WS_H);
    const int fr = lane & 15, g = lane >> 4;
    LAS unsigned char* ldsl = (LAS unsigned char*)lds;
    const int vcu = (GDIMX % 8 == 0) ? (BIDX % 8) * (GDIMX / 8) + BIDX / 8 : BIDX;
    for (int unit = vcu; unit < 1024; unit += GDIMX) {
        const int v = unit & 255, ui = unit >> 8, bh = v >> 2, s = v & 3;
        const int qb = (ui == 0) ? s : (ui == 1) ? 7 - s : (ui == 2) ? 8 + s : 15 - s;
        const int b = bh >> 3, h = bh & 7, q0 = qb * 256, NT = (q0 + 256) / 64;
        const size_t bT = (size_t)b * SEQ;
        bf16x8 qf[2][6];
#pragma unroll
        for (int qi = 0; qi < 2; ++qi)
#pragma unroll
            for (int ks = 0; ks < 6; ++ks) qf[qi][ks] = *(const bf16x8*)(Q + (bT + q0 + 32 * wave + 16 * qi + fr) * 1536 + h * QKD + 32 * ks + 8 * g);
        pg8::f32x4 oacc[8][2];
#pragma unroll
        for (int db = 0; db < 8; ++db) { oacc[db][0] = (pg8::f32x4){0.f, 0.f, 0.f, 0.f}; oacc[db][1] = (pg8::f32x4){0.f, 0.f, 0.f, 0.f}; }
        float mrun[2] = {-1e30f, -1e30f}, lsum[2] = {0.f, 0.f};
#define AT_KDMA(j, bufi) do { \
            _Pragma("unroll") for (int i = 0; i < 3; ++i) { const int blk = wave + 8 * i, kb_ = blk / 6, ks_ = blk - kb_ * 6; \
                __builtin_amdgcn_global_load_lds((const unsigned*)(Kf + (bT + 64 * (j) + 16 * kb_ + fr) * 1536 + h * QKD + 32 * ks_ + 8 * g), (LAS unsigned*)(ldsl + (bufi) * AT_KB + blk * 1024), 16, 0, 0); } } while (0)
#define AT_VDMA(j, bufi) do { \
            _Pragma("unroll") for (int i = 0; i < 2; ++i) { const int blk = wave + 8 * i; \
                __builtin_amdgcn_global_load_lds((const unsigned*)(VT + (size_t)(h * VD + 16 * (blk >> 1) + fr) * MTOK + bT + 64 * (j) + 32 * (blk & 1) + 8 * g), (LAS unsigned*)(ldsl + 2 * AT_KB + (bufi) * AT_VB + blk * 1024), 16, 0, 0); } } while (0)
#define AT_VFRAG(dst, vb, db) do { \
            dst[0] = *(const u32x4*)((vb) + ((((db) * 2 + 0) * 4 + g) * 16 + fr) * 16); dst[1] = *(const u32x4*)((vb) + ((((db) * 2 + 1) * 4 + g) * 16 + fr) * 16); } while (0)
#define AT_PV(vb) do { u32x4 vfr_[2][2]; AT_VFRAG(vfr_[0], vb, 0); \
            _Pragma("unroll") for (int db = 0; db < 8; ++db) { \
                if (db + 1 < 8) AT_VFRAG(vfr_[(db + 1) & 1], vb, db + 1); \
                __builtin_amdgcn_sched_barrier(0); \
                _Pragma("unroll") for (int k2 = 0; k2 < 2; ++k2) { \
                    const bf16x8 vfrag_ = __builtin_bit_cast(bf16x8, vfr_[db & 1][k2]); \
                    oacc[db][0] = __builtin_amdgcn_mfma_f32_16x16x32_bf16(vfrag_, pf[0][k2], oacc[db][0], 0, 0, 0); \
                    oacc[db][1] = __builtin_amdgcn_mfma_f32_16x16x32_bf16(vfrag_, pf[1][k2], oacc[db][1], 0, 0, 0); } \
                __builtin_amdgcn_sched_barrier(0); } } while (0)
        const bool lag = wave >= 4; bool pend = false;
        bf16x8 pf[2][2];
#pragma unroll
        for (int qi = 0; qi < 2; ++qi) { pf[qi][0] = (bf16x8){0, 0, 0, 0, 0, 0, 0, 0}; pf[qi][1] = (bf16x8){0, 0, 0, 0, 0, 0, 0, 0}; }
        AT_KDMA(0, 0);
        AT_VDMA(0, 0);
        asm volatile("s_waitcnt vmcnt(0) lgkmcnt(0)" ::: "memory");
        __syncthreads();
        int vi = 0, vprev = 2, vnext = 1;
        for (int j = 0; j < NT; ++j) {
            if (j + 1 < NT) { AT_KDMA(j + 1, (j + 1) & 1); AT_VDMA(j + 1, vnext); }
            const unsigned char* kb = lds + (j & 1) * AT_KB; const unsigned char* vb = lds + 2 * AT_KB + vi * AT_VB;
            if (pend) { const unsigned char* vbp = lds + 2 * AT_KB + vprev * AT_VB; AT_PV(vbp); pend = false; }
            if (64 * j <= q0 + 32 * wave + 31) {
                pg8::f32x4 sacc[4][2];
#pragma unroll
                for (int kb4 = 0; kb4 < 4; ++kb4) { sacc[kb4][0] = (pg8::f32x4){0.f, 0.f, 0.f, 0.f}; sacc[kb4][1] = (pg8::f32x4){0.f, 0.f, 0.f, 0.f}; }
                bf16x8 kfr[2][4];
#pragma unroll
                for (int kb4 = 0; kb4 < 4; ++kb4) kfr[0][kb4] = *(const bf16x8*)(kb + ((((kb4 * 6 + 0) * 4 + g) * 16 + fr) * 16));
#pragma unroll
                for (int ks = 0; ks < 6; ++ks) {
                    if (ks + 1 < 6) {
#pragma unroll
                        for (int kb4 = 0; kb4 < 4; ++kb4) kfr[(ks + 1) & 1][kb4] = *(const bf16x8*)(kb + ((((kb4 * 6 + ks + 1) * 4 + g) * 16 + fr) * 16));
                    }
                    __builtin_amdgcn_sched_barrier(0);
#pragma unroll
                    for (int kb4 = 0; kb4 < 4; ++kb4) {
                        sacc[kb4][0] = __builtin_amdgcn_mfma_f32_16x16x32_bf16(kfr[ks & 1][kb4], qf[0][ks], sacc[kb4][0], 0, 0, 0);
                        sacc[kb4][1] = __builtin_amdgcn_mfma_f32_16x16x32_bf16(kfr[ks & 1][kb4], qf[1][ks], sacc[kb4][1], 0, 0, 0);
                    }
                    __builtin_amdgcn_sched_barrier(0);
                }
                if (j >= NT - 4) {
#pragma unroll
                    for (int qi = 0; qi < 2; ++qi) { const int qpos = q0 + 32 * wave + 16 * qi + fr;
#pragma unroll
                        for (int kb4 = 0; kb4 < 4; ++kb4)
#pragma unroll
                            for (int r = 0; r < 4; ++r) if (64 * j + 16 * kb4 + 4 * g + r > qpos) sacc[kb4][qi][r] = -1e30f; }
                }
#pragma unroll
                for (int qi = 0; qi < 2; ++qi) {
                    float mx = -1e30f;
#pragma unroll
                    for (int kb4 = 0; kb4 < 4; ++kb4)
#pragma unroll
                        for (int r = 0; r < 4; ++r) mx = fmaxf(mx, sacc[kb4][qi][r]);
                    mx = fmaxf(mx, shfl_xor_l(mx, lane, 16)); mx = fmaxf(mx, shfl_xor_l(mx, lane, 32));
                    const float mnew = fmaxf(mrun[qi], mx);
                    const float alpha = __builtin_amdgcn_exp2f(mrun[qi] - mnew);
                    mrun[qi] = mnew;
                    float ps = 0.f;
#pragma unroll
                    for (int kb4 = 0; kb4 < 4; ++kb4)
#pragma unroll
                        for (int r = 0; r < 4; ++r) { const float p = __builtin_amdgcn_exp2f(sacc[kb4][qi][r] - mnew); sacc[kb4][qi][r] = p; ps += p; }
                    lsum[qi] = lsum[qi] * alpha + ps;
#pragma unroll
                    for (int db = 0; db < 8; ++db) { oacc[db][qi][0] *= alpha; oacc[db][qi][1] *= alpha; oacc[db][qi][2] *= alpha; oacc[db][qi][3] *= alpha; }
#pragma unroll
                    for (int k2 = 0; k2 < 2; ++k2) {
                        u32x4 w; w.x = pk2(sacc[2 * k2][qi][0], sacc[2 * k2][qi][1]); w.y = pk2(sacc[2 * k2][qi][2], sacc[2 * k2][qi][3]);
                        w.z = pk2(sacc[2 * k2 + 1][qi][0], sacc[2 * k2 + 1][qi][1]); w.w = pk2(sacc[2 * k2 + 1][qi][2], sacc[2 * k2 + 1][qi][3]);
                        pf[qi][k2] = __builtin_bit_cast(bf16x8, w);
                    }
                }
                if (lag) pend = true; else AT_PV(vb);
            }
            asm volatile("s_waitcnt vmcnt(0) lgkmcnt(0)" ::: "memory");
            __syncthreads();
            { const int t_ = vprev; vprev = vi; vi = vnext; vnext = t_; }
        }
        if (pend) { const unsigned char* vbp = lds + 2 * AT_KB + vprev * AT_VB; AT_PV(vbp); }
#pragma unroll
        for (int qi = 0; qi < 2; ++qi) {
            float l = lsum[qi]; l += shfl_xor_l(l, lane, 16); l += shfl_xor_l(l, lane, 32);
            const float inv = 1.f / l;
            bf16* orow = O + (bT + q0 + 32 * wave + 16 * qi + fr) * DM + h * VD + 4 * g;
#pragma unroll
            for (int db = 0; db < 8; ++db) { u32x2 w; w.x = pk2(oacc[db][qi][0] * inv, oacc[db][qi][1] * inv); w.y = pk2(oacc[db][qi][2] * inv, oacc[db][qi][3] * inv); *(u32x2*)(orow + 16 * db) = w; }
        }
        asm volatile("s_waitcnt lgkmcnt(0)" ::: "memory");
        __syncthreads();
#undef AT_VFRAG
#undef AT_PV
#undef AT_KDMA
#undef AT_VDMA
    }
}

#define XB_TMO      128
#define XB_XCNT(j)  (256  + 64 * (j))
#define XB_XSUB(j)  (1280 + 64 * (j))
#define XB_XGEN(j)  (2304 + 64 * (j))
#define XB_TOP      3328
#define XB_TOPGEN   3392
#define XCD_BAR_WORDS 3456
#define XB_SPIN_CAP (1u << 18)

__device__ __forceinline__ unsigned xb_ld(unsigned* p)              { return __hip_atomic_load(p, __ATOMIC_RELAXED, __HIP_MEMORY_SCOPE_AGENT); }
__device__ __forceinline__ unsigned xb_add(unsigned* p, unsigned v) { return __hip_atomic_fetch_add(p, v, __ATOMIC_RELAXED, __HIP_MEMORY_SCOPE_AGENT); }
__device__ __forceinline__ unsigned xb_xcc_id() { return (unsigned)__builtin_amdgcn_s_getreg((3 << 11) | 20) & 0xFu; }
#define XB_SPIN(cond, bar) do { unsigned _sp = 0; while (cond) { __builtin_amdgcn_s_sleep(1); \
    if ((++_sp & 255u) == 0u) { if (xb_ld(&(bar)[XB_TMO])) break; if (_sp > XB_SPIN_CAP) { atomicAdd(&(bar)[XB_TMO], 1u); break; } } } } while (0)

struct XcdBarrier {
    unsigned* bar; unsigned x;
    volatile LAS unsigned* st;
};

__device__ __forceinline__ XcdBarrier xcd_barrier_post(unsigned* bar, volatile LAS unsigned* st) {
    XcdBarrier b; b.bar = bar; b.x = xb_xcc_id(); b.st = st;
    if (threadIdx.x == 0) (void)xb_add(&bar[XB_XCNT(b.x)], 1u);
    return b;
}
__device__ __forceinline__ void xcd_barrier_complete(unsigned* bar, unsigned x, unsigned& nloc, unsigned& nx) {
    const unsigned G = gridDim.x * gridDim.y * gridDim.z;
    unsigned sum, cnt, mine, sp = 0u;
    for (;;) {
        sum = 0u; cnt = 0u; mine = 0u;
#pragma unroll
        for (unsigned j = 0; j < 16; ++j) { const unsigned c = xb_ld(&bar[XB_XCNT(j)]); sum += c; cnt += (c > 0u) ? 1u : 0u; mine = (j == x) ? c : mine; }
        if (sum == G) break;
        __builtin_amdgcn_s_sleep(1);
        if ((++sp & 255u) == 0u) { if (xb_ld(&bar[XB_TMO])) break; if (sp > XB_SPIN_CAP) { atomicAdd(&bar[XB_TMO], 1u); break; } }
    }
    nloc = mine > 0u ? mine : 1u; nx = cnt > 0u ? cnt : 1u;
}

__device__ __forceinline__ void xcd_barrier(const XcdBarrier& b) {
    asm volatile("s_waitcnt vmcnt(0)" ::: "memory");
    __syncthreads();
    if (threadIdx.x == 0) {
        unsigned* bar = b.bar;
        __builtin_amdgcn_s_waitcnt(0);
        unsigned nloc = b.st[0], nx = b.st[1];
        if (nloc == 0u) { xcd_barrier_complete(bar, b.x, nloc, nx); b.st[0] = nloc; b.st[1] = nx; }
        const unsigned old = xb_add(&bar[XB_XSUB(b.x)], 1u);
        const unsigned gen = old / nloc;
        if (old + 1u == (gen + 1u) * nloc) {
            __builtin_amdgcn_fence(__ATOMIC_RELEASE, "agent");
            asm volatile("s_waitcnt vmcnt(0)" ::: "memory");
            const unsigned og = xb_add(&bar[XB_TOP], 1u);
            const unsigned tg = og / nx;
            if (og + 1u == (tg + 1u) * nx) xb_add(&bar[XB_TOPGEN], 1u);
            else XB_SPIN(xb_ld(&bar[XB_TOPGEN]) == tg, bar);
            __builtin_amdgcn_fence(__ATOMIC_ACQUIRE, "agent");
            xb_add(&bar[XB_XGEN(b.x)], 1u);
            asm volatile("s_waitcnt vmcnt(0)" ::: "memory");
        } else {
            XB_SPIN(xb_ld(&bar[XB_XGEN(b.x)]) == gen, bar);
            __builtin_amdgcn_fence(__ATOMIC_ACQUIRE, "agent");
            asm volatile("s_waitcnt vmcnt(0)" ::: "memory");
        }
    }
    __syncthreads();
}

#define GEMM_ARGS true, true
#ifndef REP_SCAN
#define REP_SCAN 1
#endif
#ifndef REP_ATTN
#define REP_ATTN 1
#endif
#ifndef REP_PREP
#define REP_PREP 1
#endif
#ifndef REP_SMALL
#define REP_SMALL 1
#endif
#define WSP() ({ size_t o_ = 0; asm volatile("" : "+s"(o_)); P.ws + o_; })
#define SYNC() do { XcdBarrier xb_; xb_.bar = (unsigned*)(WSP() + WS_CTL); xb_.x = xb_xcc_id(); xb_.st = (volatile LAS unsigned*)(lds_raw + LDS_MISC); xcd_barrier(xb_); asm volatile("" : "+s"(layer), "+s"(ff)); } while (0)
#define SYNC_CG() do { grid.sync(); asm volatile("" : "+s"(layer), "+s"(ff)); } while (0)
#define TIDS() int tid_ = threadIdx.x; asm volatile("" : "+v"(tid_)); const int tid = tid_, lane = tid & 63, wave = __builtin_amdgcn_readfirstlane(tid >> 6); const int G = gdimx(), bidx_ = bidx(), gw = bidx_ * NWAVES + wave, ngw = G * NWAVES; (void)bidx_; (void)lane; (void)gw; (void)ngw; (void)G
__global__ void __launch_bounds__(NTHR, 2) mega_fwd(Params P) {
    extern __shared__ __attribute__((aligned(16))) unsigned char lds_raw[];
    cg::grid_group grid = cg::this_grid();
    int ff = 0;
    if (threadIdx.x < 4) ((volatile LAS unsigned*)(lds_raw + LDS_MISC))[threadIdx.x] = 0u;
    __syncthreads();
    (void)xcd_barrier_post((unsigned*)(P.ws + WS_CTL), (volatile LAS unsigned*)(lds_raw + LDS_MISC));
#pragma unroll 1
    for (int layer = 0; layer < DEPTH; ++layer) {
        {
            TIDS(); unsigned char* ws = WSP();
#ifndef NO_CONV_W
            convert_layer_weights(P, layer, (float*)(lds_raw + wave * 16384), gw, ngw, lane);
#endif
            rms_phase(layer == 0 ? P.in[I_X] : P.out, layer == 0 ? P.out : nullptr, P.in[I_GAINS] + (size_t)layer * 3 * DM, (bf16*)(ws + WS_H), gw, ngw, lane);
        }
        { int never_ = 0; asm volatile("" : "+s"(never_)); if (never_) SYNC_CG(); }
        SYNC();
#pragma unroll 1
        for (ff = 0; ff < 2; ++ff) {
            if (ff == 1) { TIDS(); unsigned char* ws = WSP(); rms_phase(P.out, nullptr, P.in[I_GAINS] + (size_t)layer * 3 * DM + 2 * DM, (bf16*)(ws + WS_H), gw, ngw, lane); SYNC(); }
            {
                unsigned char* ws = WSP();
                pg8::Gemm g{(const bf16*)(ws + WS_H), (const bf16*)(ws + (ff ? WS_WGU1 : WS_WGU0)), MTOK, 2 * DFF, DM}; pg8::StaticOrder S; S.init(MTOK, 2 * DFF, gdimx(), bidx());
                EpiSwiGLU E{(bf16*)(ws + WS_ACT), DFF};

#ifndef NO_G_GU
pg8::gemm_phase<EpiSwiGLU, pg8::StaticOrder, GEMM_ARGS>((LAS unsigned char*)lds_raw, g, S, E);
#endif

            }
            SYNC();
            {
                unsigned char* ws = WSP();
                pg8::Gemm g{(const bf16*)(ws + WS_ACT), (const bf16*)(ws + (ff ? WS_WD1 : WS_WD0)), MTOK, DM, DFF}; pg8::StaticOrder S; S.init(MTOK, DM, gdimx(), bidx());
                EpiResidual E{P.out, DM, 0.5f};

#ifndef NO_G_D
pg8::gemm_phase<EpiResidual, pg8::StaticOrder, GEMM_ARGS>((LAS unsigned char*)lds_raw, g, S, E);
#endif

            }
            if (!(layer == DEPTH - 1 && ff == 1)) SYNC();
            if (ff == 0) {
                { TIDS(); unsigned char* ws = WSP(); rms_phase(P.out, nullptr, P.in[I_GAINS] + (size_t)layer * 3 * DM + DM, (bf16*)(ws + WS_H), gw, ngw, lane); }
                SYNC();
                {
                    unsigned char* ws = WSP();
                    const bool even = !(layer & 1);
                    const int N = even ? 3328 : 768;
                    pg8::Gemm g{(const bf16*)(ws + WS_H), (const bf16*)(ws + WS_WIN), MTOK, N, DM}; pg8::StaticOrder S; S.init(MTOK, N, gdimx(), bidx());
                    EpiStore E;
                    if (even) { E.O0 = (bf16*)(ws + WS_PCONV); E.ldc0 = PCONV_LD; E.ntile0 = 6; E.O1 = (bf16*)(ws + WS_PRW); E.ldc1 = PRW_LD; }
                    else { E.O0 = (bf16*)(ws + WS_PODD); E.ldc0 = PODD_LD; E.ntile0 = 1 << 20; E.O1 = (bf16*)(ws + WS_PODD); E.ldc1 = PODD_LD; }

#ifndef NO_G_WIN
pg8::gemm_phase<EpiStore, pg8::StaticOrder, GEMM_ARGS>((LAS unsigned char*)lds_raw, g, S, E);
#endif

                }
                SYNC();
                if (!(layer & 1)) {
#ifndef NO_CONV
                    { unsigned char* ws = WSP(); TIDS(); conv_phase((const bf16*)(ws + WS_PCONV), P.in[I_ECONV] + (size_t)(layer >> 1) * 3 * 512, (bf16*)(ws + WS_H), bidx_ * NTHR + tid, G * NTHR); }
#endif
                    SYNC();
#ifndef NO_PREP
                    for (int rep_ = 0; rep_ < REP_PREP; ++rep_) { TIDS(); prep_phase<true>(P, layer >> 1, lds_raw, tid, wave, lane); }
#if REP_PREP == 2
                    { TIDS(); prep_phase<false>(P, layer >> 1, lds_raw, tid, wave, lane); }
#endif
#if REP_PREP == 3
                    { TIDS(); prep_phase<true>(P, layer >> 1, lds_raw, tid, wave, lane); }
#endif
#endif
                    SYNC();
#ifndef NO_SCAN
                    for (int rep_ = 0; rep_ < REP_SCAN; ++rep_) { TIDS(); scan_phase(P, (float*)lds_raw, tid, wave, lane); }
#endif
                    SYNC();
#ifndef NO_POST
                    for (int rep_ = 0; rep_ < REP_SMALL; ++rep_) { TIDS(); post_phase(P, layer >> 1, lds_raw, gw, ngw, wave, lane); }
#endif
                    SYNC();
                } else {
#ifndef NO_MLAN
                    for (int rep_ = 0; rep_ < REP_SMALL; ++rep_) { TIDS(); mla_norm_phase(P, layer >> 1, gw, ngw, lane); }
#endif
                    SYNC();
#ifndef NO_G_3
                    {   unsigned char* ws = WSP();
                        pg8::Gemm g{(const bf16*)(ws + WS_CQN), (const bf16*)(ws + WS_WQ), MTOK, 1536, QRANK}; pg8::StaticOrder S; S.init(MTOK, 1536, gdimx(), bidx());
                        EpiStore E{(bf16*)(ws + WS_QB), 1536, 1 << 20, (bf16*)(ws + WS_QB), 1536};
                        pg8::gemm_phase<EpiStore, pg8::StaticOrder, GEMM_ARGS>((LAS unsigned char*)lds_raw, g, S, E); }
                    asm volatile("" : "+s"(layer), "+s"(ff));
                    {   unsigned char* ws = WSP();
                        pg8::Gemm g{(const bf16*)(ws + WS_CKVN), (const bf16*)(ws + WS_WK), MTOK, 1024, KVRANK}; pg8::StaticOrder S; S.init(MTOK, 1024, gdimx(), bidx());
                        EpiStore E{(bf16*)(ws + WS_KNOPE), 1024, 1 << 20, (bf16*)(ws + WS_KNOPE), 1024};
                        pg8::gemm_phase<EpiStore, pg8::StaticOrder, GEMM_ARGS>((LAS unsigned char*)lds_raw, g, S, E); }
                    asm volatile("" : "+s"(layer), "+s"(ff));
                    {   unsigned char* ws = WSP();
                        pg8::Gemm g{(const bf16*)(ws + WS_WV), (const bf16*)(ws + WS_CKVN), 1024, MTOK, KVRANK}; pg8::StaticOrder S; S.init(1024, MTOK, gdimx(), bidx());
                        EpiStoreV E; E.O0 = (bf16*)(ws + WS_VT); E.ldc0 = MTOK; E.ntile0 = 1 << 20; E.O1 = E.O0; E.ldc1 = MTOK;
                        pg8::gemm_phase<EpiStoreV, pg8::StaticOrder, false, true>((LAS unsigned char*)lds_raw, g, S, E); }
#endif
                    SYNC();
#ifndef NO_QKP
                    { TIDS(); qk_prep_phase(P, layer >> 1, lds_raw, gw, ngw, wave, lane); }
#endif
                    SYNC();
#ifndef NO_ATTN
                    for (int rep_ = 0; rep_ < REP_ATTN; ++rep_) { TIDS(); attn_phase(P, lds_raw, tid, wave, lane); }
#endif
                    SYNC();
                }
                {
                    unsigned char* ws = WSP();
                    pg8::Gemm g{(const bf16*)(ws + WS_H), (const bf16*)(ws + WS_WOUT), MTOK, DM, DM}; pg8::StaticOrder S; S.init(MTOK, DM, gdimx(), bidx());
                    EpiResidual E{P.out, DM, 1.0f};

#ifndef NO_G_OUT
pg8::gemm_phase<EpiResidual, pg8::StaticOrder, GEMM_ARGS>((LAS unsigned char*)lds_raw, g, S, E);
#endif

                }
                SYNC();
            }
        }
    }
}

extern "C" void kernel_launch(void* const* d_in, const int* in_sizes, int n_in, void* d_out, int out_size, void* d_ws, size_t ws_size, hipStream_t stream) {
    static int grid = 0;
    if (grid == 0) {
        if (n_in != 28 || out_size != MTOK * DM || ws_size < WS_END) { fprintf(stderr, "kernel_launch: unexpected problem (n_in %d, out %d, ws %zu < %zu)\n", n_in, out_size, ws_size, (size_t)WS_END); grid = -1; return; }
        int dev = 0, cus = 0, per_cu = 0;
        hipGetDevice(&dev); hipDeviceGetAttribute(&cus, hipDeviceAttributeMultiprocessorCount, dev);
        hipFuncSetAttribute((const void*)mega_fwd, hipFuncAttributeMaxDynamicSharedMemorySize, LDS_BYTES);
        hipOccupancyMaxActiveBlocksPerMultiprocessor(&per_cu, (const void*)mega_fwd, NTHR, LDS_BYTES);
        if (per_cu < 1) per_cu = 1;
        grid = cus * per_cu;
        (void)hipGetLastError();
    }
    if (grid < 0) return;
    if (hipMemsetAsync((char*)d_ws + WS_CTL, 0, CTL_BYTES, stream) != hipSuccess) { fprintf(stderr, "memset failed\n"); return; }
    Params p{};
    for (int i = 0; i < 28; ++i) p.in[i] = (const float*)d_in[i];
    p.out = (float*)d_out; p.ws = (unsigned char*)d_ws;
    void* args[] = {&p};
    hipError_t e = hipLaunchCooperativeKernel((const void*)mega_fwd, dim3(grid), dim3(NTHR), args, LDS_BYTES, stream);
    if (e != hipSuccess) fprintf(stderr, "cooperative launch failed: %s (grid %d)\n", hipGetErrorString(e), grid);
}
```

```cpp
#include <hip/hip_runtime.h>
#include <hip/hip_cooperative_groups.h>
#include <cstdio>
#include <cstdint>
namespace cg = cooperative_groups;
namespace pg8 {
#define PG8_LAS __attribute__((address_space(3)))
typedef unsigned short bf16_t;
typedef short bf16x8 __attribute__((ext_vector_type(8)));
typedef float f32x4 __attribute__((ext_vector_type(4)));
typedef unsigned u32x4 __attribute__((ext_vector_type(4)));
constexpr int BM = 256, BK = 64, HALF = 128, HTB = HALF * BK * 2  , STAGE_BYTES = 8 * HTB, NXCD = 8, WGM = 8;

__host__ __device__ __forceinline__ int lds_byte(int r, int c) { const int st = (r >> 4) * 2 + (c >> 5), rr = r & 15, cc = c & 31, ob = rr * 64 + cc * 2; return st * 1024 + (ob ^ (((ob >> 9) & 1) << 5)); }
__host__ __device__ __forceinline__ void stage_rc(int b, int& R, int& C) { const int st = b / 1024, sb = b % 1024, swz = sb ^ (((sb >> 9) & 1) << 5); R = (st >> 1) * 16 + swz / 64; C = (st & 1) * 32 + (swz % 64) / 2; }
__host__ __device__ __forceinline__ int perm32(int rho) { const int n = rho >> 4, i = rho & 15; return 8 * (i >> 2) + 4 * n + (i & 3); }

struct Unit { int pm, pn; };
struct Gemm { const bf16_t* A; const bf16_t* Bt; int M, N, K; };

struct StaticOrder {
    int nM, nN, nwg, G, c;
    __host__ __device__ void init(int M, int N, int G_, int c_) { nM = M / BM; nN = N / BM; nwg = nM * nN; G = G_; c = c_; }
    __host__ __device__ bool next(int i, Unit& u) const {
        const long L = (long)i * G + c; if (L >= nwg) return false;
        int wgid = (int)L; { const int q = nwg / NXCD, r = nwg % NXCD, xcd = wgid % NXCD, off = wgid / NXCD; wgid = (xcd < r ? xcd * (q + 1) : r * (q + 1) + (xcd - r) * q) + off; }
        const int nig = WGM * nN, gid = wgid / nig, fm = gid * WGM, gsz = (nM - fm) < WGM ? (nM - fm) : WGM;
        u.pm = fm + ((wgid % nig) % gsz); u.pn = (wgid % nig) / gsz; return true;
    }
    __device__ __forceinline__ void a_ready(const Unit&) const {}
    __device__ __forceinline__ void done(const Unit&) const {}
};

__device__ __forceinline__ unsigned cvt_pk_bf16(float lo, float hi) { unsigned r; asm volatile("v_cvt_pk_bf16_f32 %0, %1, %2" : "=v"(r) : "v"(lo), "v"(hi)); return r; }
typedef float f32x2 __attribute__((ext_vector_type(2)));
template <class Epi, class Sched, bool ALIGN_EPI = false, bool SP2 = false>
__device__ __forceinline__ void gemm_phase(PG8_LAS unsigned char* lds, const Gemm g, const Sched& S, const Epi& E) {
    int tid_ = threadIdx.x; asm volatile("" : "+v"(tid_));
    const int tid = tid_, wid = __builtin_amdgcn_readfirstlane(tid >> 6), lane = tid & 63, wr = wid >> 2, wc = wid & 3, fr = lane & 15, fq = lane >> 4;
    const int K = g.K, nt = K / BK;
    unsigned voffA[2], voffB[2];
#pragma unroll
    for (int i = 0; i < 2; ++i) { int R, C; stage_rc(tid * 16 + i * 8192, R, C); const int Rb0 = Epi::PERM ? ((R & ~31) + perm32(R & 31)) : R; const int Rb = Epi::VTOK ? ((Rb0 & ~31) + 16 * ((Rb0 >> 2) & 1) + 4 * ((Rb0 >> 3) & 3) + (Rb0 & 3)) : Rb0;
        voffA[i] = (unsigned)(R * K + C) * 2u; voffB[i] = (unsigned)(Rb * K + C) * 2u; }
    const size_t kstep = (size_t)(BK * 2);
    const size_t hstep = (size_t)HALF * K * 2;
    const size_t tstep = 2 * hstep;
    const unsigned ldsw = (unsigned)wid * 1024u;
    const int aoff = lds_byte(wr * 64 + fr, fq * 8), boff = lds_byte(wc * 32 + fr, fq * 8);
#define PG8_SA(b, h) (((b) * 2 + (h)) * HTB)
#define PG8_SB(b, h) ((4 + (b) * 2 + (h)) * HTB)
#define PG8_STAGE(bufoff, gbase, voff) do { _Pragma("unroll") for (int _i = 0; _i < 2; ++_i) \
        __builtin_amdgcn_global_load_lds((const unsigned*)((const char*)(gbase) + (voff)[_i]), (PG8_LAS unsigned*)(lds + (bufoff) + ldsw + _i * 8192), 16, 0, 0); } while (0)
#define PG8_LDA(dst, b, h) do { _Pragma("unroll") for (int m = 0; m < 4; ++m) _Pragma("unroll") for (int k = 0; k < 2; ++k) dst[m][k] = *(const PG8_LAS bf16x8*)(lds + PG8_SA(b, h) + aoff + m * 2048 + k * 1024); } while (0)
#define PG8_LDB(dst, b, h) do { _Pragma("unroll") for (int n = 0; n < 2; ++n) _Pragma("unroll") for (int k = 0; k < 2; ++k) dst[n][k] = *(const PG8_LAS bf16x8*)(lds + PG8_SB(b, h) + boff + n * 2048 + k * 1024); } while (0)
#define PG8_MMA(ai, bj, At, Bt) do { __builtin_amdgcn_s_setprio(1); _Pragma("unroll") for (int m = 0; m < 4; ++m) _Pragma("unroll") for (int n = 0; n < 2; ++n) _Pragma("unroll") for (int k = 0; k < 2; ++k) \
        acc[ai][bj][m][n] = __builtin_amdgcn_mfma_f32_16x16x32_bf16(Bt[n][k], At[m][k], acc[ai][bj][m][n], 0, 0, 0); __builtin_amdgcn_s_setprio(0); } while (0)
#define PG8_WAIT_V(n) asm volatile("s_waitcnt vmcnt(" #n ")" ::: "memory")
#define PG8_WAIT_L(n) asm volatile("s_waitcnt lgkmcnt(" #n ")" ::: "memory")
#define PG8_BAR __builtin_amdgcn_s_barrier()
#define PG8_SCHED __builtin_amdgcn_sched_barrier(0)
    Unit cur, nxt; int ui = 0;
    if (!S.next(0, cur)) return;
    f32x4 acc[2][2][4][2];
#pragma unroll
    for (int a = 0; a < 2; ++a)
#pragma unroll
        for (int b = 0; b < 2; ++b)
#pragma unroll
            for (int m = 0; m < 4; ++m)
#pragma unroll
                for (int n = 0; n < 2; ++n) acc[a][b][m][n] = (f32x4){0.f, 0.f, 0.f, 0.f};
    bf16x8 At[4][2], B0[2][2], B1[2][2];
    const char* cA = (const char*)g.A + (size_t)cur.pm * tstep; const char* cB = (const char*)g.Bt + (size_t)cur.pn * tstep;
    S.a_ready(cur);
    if constexpr (SP2) {
        PG8_STAGE(PG8_SB(0, 0), cB, voffB); PG8_STAGE(PG8_SB(0, 1), cB + hstep, voffB); PG8_STAGE(PG8_SA(0, 0), cA, voffA); PG8_STAGE(PG8_SA(0, 1), cA + hstep, voffA);
        if (wr == 1) PG8_BAR;
        PG8_WAIT_V(2); PG8_BAR;
        PG8_STAGE(PG8_SB(1, 0), cB + kstep, voffB); PG8_STAGE(PG8_SA(1, 0), cA + kstep, voffA); PG8_STAGE(PG8_SB(1, 1), cB + hstep + kstep, voffB);
        PG8_WAIT_V(6); PG8_BAR;
    } else {
        PG8_STAGE(PG8_SB(0, 0), cB, voffB); PG8_STAGE(PG8_SA(0, 0), cA, voffA); PG8_STAGE(PG8_SB(0, 1), cB + hstep, voffB); PG8_STAGE(PG8_SA(0, 1), cA + hstep, voffA);
        if (wr == 1) PG8_BAR;
        PG8_WAIT_V(4); PG8_BAR;
        PG8_STAGE(PG8_SB(1, 0), cB + kstep, voffB); PG8_STAGE(PG8_SA(1, 0), cA + kstep, voffA); PG8_STAGE(PG8_SB(1, 1), cB + hstep + kstep, voffB);
        PG8_WAIT_V(6); PG8_BAR;
    }
    for (;;) {
        const bool has_next = S.next(ui + 1, nxt);
        const char* nA = has_next ? (const char*)g.A + (size_t)nxt.pm * tstep : cA; const char* nB = has_next ? (const char*)g.Bt + (size_t)nxt.pn * tstep : cB;
        for (int t = 0; t < nt; t += 2) {
            const bool last = (t == nt - 2);
            const char* a1 = cA + (size_t)(t + 1) * kstep;
            const char* a2 = last ? nA : cA + (size_t)(t + 2) * kstep; const char* b2 = last ? nB : cB + (size_t)(t + 2) * kstep;
            const char* a3 = a2 + kstep; const char* b3 = b2 + kstep;
            if (last && has_next) S.a_ready(nxt);
            if constexpr (SP2) {
            PG8_LDB(B0, 0, 0); PG8_LDB(B1, 0, 1); PG8_SCHED; PG8_LDA(At, 0, 0); PG8_STAGE(PG8_SA(1, 1), a1 + hstep, voffA);
            PG8_WAIT_V(8); PG8_WAIT_L(0); PG8_BAR; PG8_MMA(0, 0, At, B0); PG8_MMA(0, 1, At, B1); PG8_BAR; PG8_SCHED;
            PG8_LDA(At, 0, 1); PG8_STAGE(PG8_SB(0, 0), b2, voffB); PG8_STAGE(PG8_SB(0, 1), b2 + hstep, voffB); PG8_STAGE(PG8_SA(0, 0), a2, voffA);
            PG8_WAIT_V(8); PG8_WAIT_L(0); PG8_BAR; PG8_MMA(1, 0, At, B0); PG8_MMA(1, 1, At, B1); PG8_BAR; PG8_SCHED;
            PG8_LDB(B0, 1, 0); PG8_LDB(B1, 1, 1); PG8_SCHED; PG8_LDA(At, 1, 0); PG8_STAGE(PG8_SA(0, 1), a2 + hstep, voffA);
            PG8_WAIT_V(8); PG8_WAIT_L(0); PG8_BAR; PG8_MMA(0, 0, At, B0); PG8_MMA(0, 1, At, B1); PG8_BAR; PG8_SCHED;
            PG8_LDA(At, 1, 1); PG8_STAGE(PG8_SB(1, 0), b3, voffB); PG8_STAGE(PG8_SB(1, 1), b3 + hstep, voffB); PG8_STAGE(PG8_SA(1, 0), a3, voffA);
            PG8_WAIT_V(8); PG8_WAIT_L(0); PG8_BAR; PG8_MMA(1, 0, At, B0); PG8_MMA(1, 1, At, B1); PG8_BAR; PG8_SCHED;
            } else {
            PG8_LDB(B0, 0, 0); PG8_SCHED; PG8_LDA(At, 0, 0); PG8_STAGE(PG8_SA(1, 1), a1 + hstep, voffA);
            PG8_WAIT_L(8); PG8_BAR; PG8_WAIT_L(0); PG8_MMA(0, 0, At, B0); PG8_BAR; PG8_SCHED;
            PG8_LDB(B1, 0, 1); PG8_STAGE(PG8_SB(0, 0), b2, voffB);
            PG8_BAR; PG8_WAIT_L(0); PG8_MMA(0, 1, At, B1); PG8_BAR;
            PG8_LDA(At, 0, 1); PG8_STAGE(PG8_SA(0, 0), a2, voffA);
            PG8_BAR; PG8_WAIT_L(0); PG8_MMA(1, 0, At, B0); PG8_BAR; PG8_SCHED;
            PG8_STAGE(PG8_SB(0, 1), b2 + hstep, voffB);
            PG8_WAIT_V(6); PG8_BAR; PG8_MMA(1, 1, At, B1); PG8_BAR;
            PG8_LDB(B0, 1, 0); PG8_SCHED; PG8_LDA(At, 1, 0); PG8_STAGE(PG8_SA(0, 1), a2 + hstep, voffA);
            PG8_WAIT_L(8); PG8_BAR; PG8_WAIT_L(0); PG8_MMA(0, 0, At, B0); PG8_BAR; PG8_SCHED;
            PG8_LDB(B1, 1, 1); PG8_STAGE(PG8_SB(1, 0), b3, voffB);
            PG8_BAR; PG8_WAIT_L(0); PG8_MMA(0, 1, At, B1); PG8_BAR;
            PG8_LDA(At, 1, 1); PG8_STAGE(PG8_SA(1, 0), a3, voffA);
            PG8_BAR; PG8_WAIT_L(0); PG8_MMA(1, 0, At, B0); PG8_BAR; PG8_SCHED;
            PG8_STAGE(PG8_SB(1, 1), b3 + hstep, voffB);
            PG8_WAIT_V(6); PG8_BAR; PG8_MMA(1, 1, At, B1); PG8_BAR;
            }
        }
        if constexpr (ALIGN_EPI) { if (wr == 0) PG8_BAR; }
        if constexpr (!Epi::AFTER_DRAIN) { E(acc, cur, wr, wc, fr, fq); S.done(cur); }
        if (!has_next) break;
#pragma unroll
        for (int a = 0; a < 2; ++a)
#pragma unroll
            for (int b = 0; b < 2; ++b)
#pragma unroll
                for (int m = 0; m < 4; ++m)
#pragma unroll
                    for (int n = 0; n < 2; ++n) acc[a][b][m][n] = (f32x4){0.f, 0.f, 0.f, 0.f};
        cur = nxt; cA = nA; cB = nB; ++ui;
        if constexpr (ALIGN_EPI) { if (wr == 1) PG8_BAR; }
    }
    PG8_WAIT_V(0);
    if constexpr (!ALIGN_EPI) { if (wr == 0) PG8_BAR; }
    PG8_BAR;
    if constexpr (Epi::AFTER_DRAIN) { E.fused(acc, cur, wr, wc, fr, fq, lds, wid, lane); S.done(cur); }
#undef PG8_SA
#undef PG8_SB
#undef PG8_STAGE
#undef PG8_LDA
#undef PG8_LDB
#undef PG8_MMA
#undef PG8_WAIT_V
#undef PG8_WAIT_L
#undef PG8_BAR
#undef PG8_SCHED
}
}

constexpr int DM = 1024, NB = 8, SEQ = 4096, DEPTH = 4, MTOK = NB * SEQ;
constexpr int DFF = 2816;
constexpr int EVEN_IN = 3232, RW_COLS = 1696, PCONV_LD = 1536, PRW_LD = 1792;
constexpr int ODD_IN = 704, PODD_LD = 768, QRANK = 384, KVRANK = 256;
constexpr int NH = 8, QKD = 192, VD = 128;
constexpr float NORM_EPS = 1e-6f, GN_EPS = 64e-5f;
constexpr int NWAVES = 8, NTHR = 512;

typedef unsigned short bf16;
typedef unsigned u32x4 __attribute__((ext_vector_type(4)));
typedef unsigned u32x2 __attribute__((ext_vector_type(2)));
typedef float f32x4 __attribute__((ext_vector_type(4)));
typedef float f32x2 __attribute__((ext_vector_type(2)));
typedef short bf16x8 __attribute__((ext_vector_type(8)));
#define LAS __attribute__((address_space(3)))

constexpr size_t MiB = 1u << 20;
constexpr size_t WS_WGU0 = 0, WS_WD0 = WS_WGU0 + (size_t)2 * DFF * DM * 2, WS_WGU1 = WS_WD0 + (size_t)DM * DFF * 2, WS_WD1 = WS_WGU1 + (size_t)2 * DFF * DM * 2;
constexpr size_t WS_WMIX = 33 * MiB;
static_assert(WS_WD1 + (size_t)DM * DFF * 2 <= WS_WMIX, "ffn weights");
constexpr size_t WS_WIN = WS_WMIX;
constexpr size_t WS_WOUT = WS_WMIX + 7 * MiB;
constexpr size_t WS_WQ = WS_WMIX + 9 * MiB;
constexpr size_t WS_WK = WS_WMIX + 11 * MiB;
constexpr size_t WS_WV = WS_WMIX + 12 * MiB;
constexpr size_t WS_CTL = 47 * MiB, CTL_BYTES = 16384;
constexpr size_t WS_H = 48 * MiB;
constexpr size_t WS_R = 112 * MiB;
constexpr size_t WS_ACT = WS_R;
constexpr size_t WS_PRW = WS_R;
constexpr size_t WS_PCONV = WS_R + 112 * MiB;
constexpr size_t WS_OPS = WS_R + 112 * MiB;
constexpr size_t WS_GBUF = WS_R + 304 * MiB;
constexpr size_t WS_SCAL = WS_R + 336 * MiB;
constexpr size_t WS_YRAW = WS_R;
constexpr size_t WS_PODD = WS_R;
constexpr size_t WS_CQN = WS_R + 48 * MiB;
constexpr size_t WS_CKVN = WS_R + 72 * MiB;
constexpr size_t WS_KF = WS_R;
constexpr size_t WS_QB = WS_R + 96 * MiB;
constexpr size_t WS_KNOPE = WS_R + 192 * MiB;
constexpr size_t WS_VT = WS_R + 256 * MiB;
constexpr size_t WS_KPE = WS_R + 320 * MiB;
constexpr size_t WS_END = WS_R + 340 * MiB;

constexpr int LDS_MISC = 131072 + 320;
constexpr int LDS_BYTES = 147456;

__device__ __forceinline__ float bf2f(bf16 b) { return __uint_as_float((unsigned)b << 16); }
__device__ __forceinline__ float bflo(unsigned w) { return __uint_as_float(w << 16); }
__device__ __forceinline__ float bfhi(unsigned w) { return __uint_as_float(w & 0xffff0000u); }
__device__ __forceinline__ unsigned pk2(float lo, float hi) { return pg8::cvt_pk_bf16(lo, hi); }
__device__ __forceinline__ bf16 f2bf(float f) { return (bf16)(pk2(f, 0.f) & 0xffffu); }
__device__ __forceinline__ float shfl_xor_l(float v, int lane, int mask) { return __int_as_float(__builtin_amdgcn_ds_bpermute((lane ^ mask) << 2, __float_as_int(v))); }
__device__ __forceinline__ void unpack8(const u32x4 w, float (&f)[8]) { f[0] = bflo(w.x); f[1] = bfhi(w.x); f[2] = bflo(w.y); f[3] = bfhi(w.y); f[4] = bflo(w.z); f[5] = bfhi(w.z); f[6] = bflo(w.w); f[7] = bfhi(w.w); }
__device__ __forceinline__ u32x4 pack8(const float (&f)[8]) { u32x4 w; w.x = pk2(f[0], f[1]); w.y = pk2(f[2], f[3]); w.z = pk2(f[4], f[5]); w.w = pk2(f[6], f[7]); return w; }
__device__ __forceinline__ int bidx() { int b = blockIdx.x; asm volatile("" : "+s"(b)); return b; }
__device__ __forceinline__ int gdimx() { int g = gridDim.x; asm volatile("" : "+s"(g)); return g; }
__device__ __forceinline__ float sigmoidf_(float x) { return 1.f / (1.f + __expf(-x)); }
template <int CTRL> __device__ __forceinline__ float dpp_f(float x) { return __int_as_float(__builtin_amdgcn_update_dpp(0, __float_as_int(x), CTRL, 0xF, 0xF, false)); }
__device__ __forceinline__ float row16_sum(float x) {
    x += dpp_f<0x128>(x); x += dpp_f<0x124>(x); x += dpp_f<0x122>(x); x += dpp_f<0x121>(x); return x;
}
__device__ __forceinline__ float wave_sum(float v) {
    v = row16_sum(v);
    const float a = __int_as_float(__builtin_amdgcn_readlane(__float_as_int(v), 0)), b = __int_as_float(__builtin_amdgcn_readlane(__float_as_int(v), 16));
    const float c = __int_as_float(__builtin_amdgcn_readlane(__float_as_int(v), 32)), d = __int_as_float(__builtin_amdgcn_readlane(__float_as_int(v), 48));
    return (a + b) + (c + d);
}

struct EpiStore {
    static constexpr bool PERM = true, AFTER_DRAIN = false, VTOK = false;
    bf16* O0; int ldc0; int ntile0; bf16* O1; int ldc1;
    __device__ __forceinline__ void operator()(const pg8::f32x4 (&acc)[2][2][4][2], const pg8::Unit& u, int wr, int wc, int fr, int fq) const {
        const int row0 = u.pm * 256 + wr * 64 + fr;
        bf16* base; int ldc, colt;
        if (u.pn < ntile0) { base = O0; ldc = ldc0; colt = u.pn * 256; } else { base = O1; ldc = ldc1; colt = (u.pn - ntile0) * 256; }
        const int col0 = colt + wc * 32 + 8 * fq;
#pragma unroll
        for (int ai = 0; ai < 2; ++ai)
#pragma unroll
            for (int m = 0; m < 4; ++m) {
                bf16* rowp = base + (size_t)(row0 + ai * 128 + m * 16) * ldc + col0;
#pragma unroll
                for (int bj = 0; bj < 2; ++bj) {
                    const pg8::f32x4 v0 = acc[ai][bj][m][0], v1 = acc[ai][bj][m][1];
                    u32x4 w; w.x = pk2(v0[0], v0[1]); w.y = pk2(v0[2], v0[3]); w.z = pk2(v1[0], v1[1]); w.w = pk2(v1[2], v1[3]);
                    *(u32x4*)(rowp + bj * 128) = w;
                }
            }
    }
};
struct EpiStoreV : EpiStore { static constexpr bool VTOK = true; };
struct EpiSwiGLU {
    static constexpr bool PERM = true, AFTER_DRAIN = false, VTOK = false;
    bf16* O; int ldc;
    __device__ __forceinline__ void operator()(const pg8::f32x4 (&acc)[2][2][4][2], const pg8::Unit& u, int wr, int wc, int fr, int fq) const {
        const int row0 = u.pm * 256 + wr * 64 + fr;
        const int col0 = u.pn * 128 + wc * 32 + 8 * fq;
#pragma unroll
        for (int ai = 0; ai < 2; ++ai)
#pragma unroll
            for (int m = 0; m < 4; ++m) {
                bf16* rowp = O + (size_t)(row0 + ai * 128 + m * 16) * ldc + col0;
                float r[8];
#pragma unroll
                for (int n = 0; n < 2; ++n)
#pragma unroll
                    for (int j = 0; j < 4; ++j) {
                        const float g = acc[ai][0][m][n][j], up = acc[ai][1][m][n][j];
                        const float s = g * __builtin_amdgcn_rcpf(1.f + __builtin_amdgcn_exp2f(-1.4426950408889634f * g));
                        r[n * 4 + j] = s * up;
                    }
                u32x4 w; w.x = pk2(r[0], r[1]); w.y = pk2(r[2], r[3]); w.z = pk2(r[4], r[5]); w.w = pk2(r[6], r[7]);
                *(u32x4*)rowp = w;
            }
    }
};
struct EpiResidual {
    static constexpr bool PERM = false, AFTER_DRAIN = false, VTOK = false;
    float* X; int ldc; float scale;
    __device__ __forceinline__ void operator()(const pg8::f32x4 (&acc)[2][2][4][2], const pg8::Unit& u, int wr, int wc, int fr, int fq) const {
        const int row0 = u.pm * 256 + wr * 64 + fr;
        const int col0 = u.pn * 256 + wc * 32 + 4 * fq;
#pragma unroll
        for (int ai = 0; ai < 2; ++ai)
#pragma unroll
            for (int m = 0; m < 4; ++m) {
                float* rowp = X + (size_t)(row0 + ai * 128 + m * 16) * ldc + col0;
#pragma unroll
                for (int bj = 0; bj < 2; ++bj)
#pragma unroll
                    for (int n = 0; n < 2; ++n) {
                        f32x4* p = (f32x4*)(rowp + bj * 128 + n * 16);
                        f32x4 v = *p; const pg8::f32x4 a = acc[ai][bj][m][n];
                        v[0] += scale * a[0]; v[1] += scale * a[1]; v[2] += scale * a[2]; v[3] += scale * a[3];
                        *p = v;
                    }
            }
    }
};

__device__ __forceinline__ void tr_item(const float* W, int ldw, int col0, int k0, bf16* WT, int K, int drow0, float* scr, int lane) {
#pragma unroll 8
    for (int i = 0; i < 32; ++i) { const int kk = 2 * i + (lane >> 5); scr[kk * 33 + (lane & 31)] = W[(size_t)(k0 + kk) * ldw + col0 + (lane & 31)]; }
    asm volatile("s_waitcnt lgkmcnt(0)" ::: "memory");
    const int c = lane & 7;
#pragma unroll
    for (int j = 0; j < 4; ++j) {
        const int n = (lane >> 3) + 8 * j; const float* s = scr + (8 * c) * 33 + n;
        u32x4 o; o.x = pk2(s[0 * 33], s[1 * 33]); o.y = pk2(s[2 * 33], s[3 * 33]); o.z = pk2(s[4 * 33], s[5 * 33]); o.w = pk2(s[6 * 33], s[7 * 33]);
        *(u32x4*)(WT + (size_t)(drow0 + n) * K + k0 + 8 * c) = o;
    }
    asm volatile("s_waitcnt lgkmcnt(0)" ::: "memory");
}

struct Params { const float* in[28]; float* out; unsigned char* ws; };
enum { I_X = 0, I_POS, I_GAINS, I_FG, I_FU, I_FD, I_EWIN, I_ECONV, I_EMU, I_W0, I_WUP, I_A0, I_AUP, I_GUP, I_KK, I_KA, I_RK, I_LNW, I_LNB, I_EWOUT,
       I_OWIN, I_QAN, I_KVAN, I_WQUP, I_WKVUP, I_QN, I_KN, I_OWOUT };

__device__ __forceinline__ void convert_layer_weights(const Params& P, int layer, float* scr, int gw, int ngw, int lane) {
    unsigned char* ws = P.ws;
    const int idx = layer >> 1; const bool even = !(layer & 1);
    constexpr int N_GU = (2 * DFF / 32) * (DM / 64);
    constexpr int N_D = (DM / 32) * (DFF / 64);
    constexpr int N_EWIN = (EVEN_IN / 32) * (DM / 64);
    constexpr int N_SQ = (DM / 32) * (DM / 64);
    constexpr int N_OWIN = (ODD_IN / 32) * (DM / 64);
    constexpr int N_WQ = (1536 / 32) * (QRANK / 64);
    constexpr int N_WKV = (1024 / 32) * (KVRANK / 64);
    const int nmix = even ? (N_EWIN + N_SQ) : (N_OWIN + N_WQ + 2 * N_WKV + N_SQ);
    const int total = 2 * (N_GU + N_D) + nmix;
    for (int it = gw; it < total; it += ngw) {
        int r = it;
        if (r < 2 * (N_GU + N_D)) {
            const int ff = r / (N_GU + N_D); r -= ff * (N_GU + N_D);
            const size_t woff = (size_t)(layer * 2 + ff) * DM * DFF;
            if (r < N_GU) {
                const int nb = r % 176, kb = r / 176, nd = 32 * nb, pn = nd >> 8, within = nd & 255, sel = within >> 7;
                const float* src = (sel ? P.in[I_FU] : P.in[I_FG]) + woff;
                tr_item(src, DFF, 128 * pn + (within & 127), 64 * kb, (bf16*)(ws + (ff ? WS_WGU1 : WS_WGU0)), DM, nd, scr, lane);
            } else {
                r -= N_GU; const int nb = r % 32, kb = r / 32;
                tr_item(P.in[I_FD] + woff, DM, 32 * nb, 64 * kb, (bf16*)(ws + (ff ? WS_WD1 : WS_WD0)), DFF, 32 * nb, scr, lane);
            }
            continue;
        }
        r -= 2 * (N_GU + N_D);
        if (even) {
            if (r < N_EWIN) { const int nb = r % 101, kb = r / 101; tr_item(P.in[I_EWIN] + (size_t)idx * DM * EVEN_IN, EVEN_IN, 32 * nb, 64 * kb, (bf16*)(ws + WS_WIN), DM, 32 * nb, scr, lane); continue; }
            r -= N_EWIN;
            { const int nb = r % 32, kb = r / 32; tr_item(P.in[I_EWOUT] + (size_t)idx * DM * DM, DM, 32 * nb, 64 * kb, (bf16*)(ws + WS_WOUT), DM, 32 * nb, scr, lane); }
        } else {
            if (r < N_OWIN) { const int nb = r % 22, kb = r / 22; tr_item(P.in[I_OWIN] + (size_t)idx * DM * ODD_IN, ODD_IN, 32 * nb, 64 * kb, (bf16*)(ws + WS_WIN), DM, 32 * nb, scr, lane); continue; }
            r -= N_OWIN;
            if (r < N_WQ) { const int nb = r % 48, kb = r / 48; tr_item(P.in[I_WQUP] + (size_t)idx * QRANK * 1536, 1536, 32 * nb, 64 * kb, (bf16*)(ws + WS_WQ), QRANK, 32 * nb, scr, lane); continue; }
            r -= N_WQ;
            if (r < 2 * N_WKV) {
                const int sel = r / N_WKV; r -= sel * N_WKV;
                const int nb = r % 32, kb = r / 32, nd = 32 * nb;
                tr_item(P.in[I_WKVUP] + (size_t)idx * KVRANK * 2048, 2048, (nd >> 7) * 256 + sel * 128 + (nd & 127), 64 * kb, (bf16*)(ws + (sel ? WS_WV : WS_WK)), KVRANK, nd, scr, lane);
                continue;
            }
            r -= 2 * N_WKV;
            { const int nb = r % 32, kb = r / 32; tr_item(P.in[I_OWOUT] + (size_t)idx * DM * DM, DM, 32 * nb, 64 * kb, (bf16*)(ws + WS_WOUT), DM, 32 * nb, scr, lane); }
        }
    }
}

__device__ __forceinline__ void rms_phase(const float* src, float* cpy, const float* gain, bf16* dst, int gw, int ngw, int lane) {
    f32x4 g[4];
#pragma unroll
    for (int j = 0; j < 4; ++j) g[j] = ((const f32x4*)gain)[lane + 64 * j];
    for (int m = 2 * gw; m < MTOK; m += 2 * ngw) {
        f32x4 v[2][4]; float s[2] = {0.f, 0.f};
#pragma unroll
        for (int u = 0; u < 2; ++u) { const f32x4* xr = (const f32x4*)(src + (size_t)(m + u) * DM) + lane;
#pragma unroll
            for (int j = 0; j < 4; ++j) v[u][j] = xr[64 * j]; }
#pragma unroll
        for (int u = 0; u < 2; ++u) {
#pragma unroll
            for (int j = 0; j < 4; ++j) s[u] += (v[u][j].x * v[u][j].x + v[u][j].y * v[u][j].y) + (v[u][j].z * v[u][j].z + v[u][j].w * v[u][j].w);
            if (cpy) { f32x4* cr = (f32x4*)(cpy + (size_t)(m + u) * DM) + lane;
#pragma unroll
                for (int j = 0; j < 4; ++j) cr[64 * j] = v[u][j]; }
        }
#pragma unroll
        for (int u = 0; u < 2; ++u) {
            const float rstd = rsqrtf(wave_sum(s[u]) * (1.f / DM) + NORM_EPS);
            u32x2* o8 = (u32x2*)(dst + (size_t)(m + u) * DM) + lane;
#pragma unroll
            for (int j = 0; j < 4; ++j) { u32x2 o; o.x = pk2(v[u][j].x * rstd * g[j].x, v[u][j].y * rstd * g[j].y); o.y = pk2(v[u][j].z * rstd * g[j].z, v[u][j].w * rstd * g[j].w); o8[64 * j] = o; }
        }
    }
}

__device__ __forceinline__ void conv_phase(const bf16* pconv, const float* cw, bf16* ycat, int gtid, int nthr) {
#pragma unroll 2
    for (int item = gtid; item < MTOK * 64; item += nthr) {
        const int m = item >> 6, c8 = (item & 63) * 8, t = m & (SEQ - 1);
        const bf16* row = pconv + (size_t)m * PCONV_LD;
        const u32x4 gb = *(const u32x4*)(row + c8), gc0 = *(const u32x4*)(row + 512 + c8), hi0 = *(const u32x4*)(row + 1024 + c8);
        const bf16* row1 = t >= 1 ? row - PCONV_LD : row; const bf16* row2 = t >= 2 ? row - 2 * PCONV_LD : row;
        u32x4 gc1 = *(const u32x4*)(row1 + 512 + c8), hi1 = *(const u32x4*)(row1 + 1024 + c8), gc2 = *(const u32x4*)(row2 + 512 + c8), hi2 = *(const u32x4*)(row2 + 1024 + c8);
        const unsigned k1 = t >= 1 ? 0xffffffffu : 0u, k2 = t >= 2 ? 0xffffffffu : 0u;
        gc1.x &= k1; gc1.y &= k1; gc1.z &= k1; gc1.w &= k1; gc2.x &= k2; gc2.y &= k2; gc2.z &= k2; gc2.w &= k2;
        float y[8];
#pragma unroll
        for (int e = 0; e < 4; ++e) {
            const float w0a = cw[c8 + 2 * e], w0b = cw[c8 + 2 * e + 1], w1a = cw[512 + c8 + 2 * e], w1b = cw[512 + c8 + 2 * e + 1], w2a = cw[1024 + c8 + 2 * e], w2b = cw[1024 + c8 + 2 * e + 1];
            const float u0a = bflo(gc0[e]) * bflo(hi0[e]), u0b = bfhi(gc0[e]) * bfhi(hi0[e]);
            const float u1a = bflo(gc1[e]) * bflo(hi1[e]), u1b = bfhi(gc1[e]) * bfhi(hi1[e]);
            const float u2a = bflo(gc2[e]) * bflo(hi2[e]), u2b = bfhi(gc2[e]) * bfhi(hi2[e]);
            y[2 * e] = bflo(gb[e]) * (w0a * u2a + w1a * u1a + w2a * u0a);
            y[2 * e + 1] = bfhi(gb[e]) * (w0b * u2b + w1b * u1b + w2b * u0b);
        }
        u32x4 o; o.x = pk2(y[0], y[1]); o.y = pk2(y[2], y[3]); o.z = pk2(y[4], y[5]); o.w = pk2(y[6], y[7]);
        *(u32x4*)(ycat + (size_t)m * DM + c8) = o;
    }
}

constexpr int PP_LIN_LD = 168;
constexpr int PP_CST = 8192, PP_GFR = 32768;
__device__ __forceinline__ float fast_sigmoid(float x) { return __builtin_amdgcn_rcpf(1.f + __expf(-x)); }
template <bool STORE> __device__ __forceinline__ void prep_phase(const Params& P, int idx, unsigned char* lds, int tid, int wave, int lane) {
    const int BIDX = bidx(), GDIMX = gdimx();
    const bf16* prw = (const bf16*)(P.ws + WS_PRW);
    bf16* ops = (bf16*)(P.ws + WS_OPS); bf16* gbuf = (bf16*)(P.ws + WS_GBUF); float* scal = (float*)(P.ws + WS_SCAL);
    const float* mu = P.in[I_EMU] + (size_t)idx * RW_COLS;
    const int fr = lane & 15, g = lane >> 4, h = wave;
    bf16* lin = (bf16*)lds; float* cst = (float*)(lds + PP_CST);
    cst[0 * 512 + tid] = P.in[I_W0][idx * 512 + tid]; cst[1 * 512 + tid] = P.in[I_A0][idx * 512 + tid]; cst[2 * 512 + tid] = P.in[I_KK][idx * 512 + tid]; cst[3 * 512 + tid] = P.in[I_KA][idx * 512 + tid];
    cst[4 * 512 + tid] = P.in[I_RK][idx * 512 + tid]; cst[5 * 512 + tid] = mu[tid]; cst[6 * 512 + tid] = mu[512 + tid]; cst[7 * 512 + tid] = mu[1024 + tid];
    bf16x8 wfr[4], afr[4];
    const float* wup = P.in[I_WUP] + (size_t)idx * 32 * 512; const float* aup = P.in[I_AUP] + (size_t)idx * 32 * 512; const float* gup = P.in[I_GUP] + (size_t)idx * 96 * 512;
#pragma unroll
    for (int nb = 0; nb < 4; ++nb) {
        const int col = 64 * h + 16 * nb + fr;
        u32x4 ww, aa;
        ww.x = pk2(wup[(8 * g + 0) * 512 + col], wup[(8 * g + 1) * 512 + col]); ww.y = pk2(wup[(8 * g + 2) * 512 + col], wup[(8 * g + 3) * 512 + col]);
        ww.z = pk2(wup[(8 * g + 4) * 512 + col], wup[(8 * g + 5) * 512 + col]); ww.w = pk2(wup[(8 * g + 6) * 512 + col], wup[(8 * g + 7) * 512 + col]);
        aa.x = pk2(aup[(8 * g + 0) * 512 + col], aup[(8 * g + 1) * 512 + col]); aa.y = pk2(aup[(8 * g + 2) * 512 + col], aup[(8 * g + 3) * 512 + col]);
        aa.z = pk2(aup[(8 * g + 4) * 512 + col], aup[(8 * g + 5) * 512 + col]); aa.w = pk2(aup[(8 * g + 6) * 512 + col], aup[(8 * g + 7) * 512 + col]);
        wfr[nb] = __builtin_bit_cast(bf16x8, ww); afr[nb] = __builtin_bit_cast(bf16x8, aa);
#pragma unroll
        for (int ks = 0; ks < 3; ++ks) {
            const int kb = 32 * ks + 8 * g; u32x4 gg_;
            gg_.x = pk2(gup[(kb + 0) * 512 + col], gup[(kb + 1) * 512 + col]); gg_.y = pk2(gup[(kb + 2) * 512 + col], gup[(kb + 3) * 512 + col]);
            gg_.z = pk2(gup[(kb + 4) * 512 + col], gup[(kb + 5) * 512 + col]); gg_.w = pk2(gup[(kb + 6) * 512 + col], gup[(kb + 7) * 512 + col]);
            *(u32x4*)(lds + PP_GFR + ((((h * 3 + ks) * 4 + nb) * 64 + lane) * 16)) = gg_;
        }
    }
    __syncthreads();
    for (int tile = BIDX; tile < MTOK / 16; tile += GDIMX) {
        const int m0 = tile * 16;
        if (tid < 320) {
            const int tok = tid / 20, ch = tid - tok * 20, m = m0 + tok, t = m & (SEQ - 1);
            const u32x4 wc = *(const u32x4*)(prw + (size_t)m * PRW_LD + 1536 + 8 * ch);
            const u32x4 wp = *(const u32x4*)(prw + (size_t)(t ? m - 1 : m) * PRW_LD + 1536 + 8 * ch);
            const f32x4 mu0 = *(const f32x4*)(mu + 1536 + 8 * ch), mu1 = *(const f32x4*)(mu + 1536 + 8 * ch + 4);
            float cur[8], prv[8], f[8]; unpack8(wc, cur); unpack8(wp, prv);
            const float mus[8] = {mu0.x, mu0.y, mu0.z, mu0.w, mu1.x, mu1.y, mu1.z, mu1.w};
#pragma unroll
            for (int e = 0; e < 8; ++e) {
                const float pv = t ? prv[e] : 0.f;
                const float x = cur[e] + (pv - cur[e]) * mus[e];
                const float th = 1.f - 2.f * __builtin_amdgcn_rcpf(1.f + __expf(2.f * x)), sg = fast_sigmoid(x);
                f[e] = ch < 4 ? th : (ch < 8 ? x : sg);
            }
            *(u32x4*)(lin + tok * PP_LIN_LD + 8 * ch) = pack8(f);
        }
        __syncthreads();
        const int m = m0 + fr, t = m & (SEQ - 1), b = m >> 12;
        const bf16* row = prw + (size_t)m * PRW_LD + 64 * h + 4 * g;
        u32x2 rc[4], kc[4], vc[4], rp[4], kp[4], vp[4];
#pragma unroll
        for (int nb = 0; nb < 4; ++nb) { rc[nb] = *(const u32x2*)(row + 16 * nb); kc[nb] = *(const u32x2*)(row + 512 + 16 * nb); vc[nb] = *(const u32x2*)(row + 1024 + 16 * nb); }
        {   const bf16* prow = t ? row - PRW_LD : row; const unsigned keep = t ? 0xffffffffu : 0u;
#pragma unroll
            for (int nb = 0; nb < 4; ++nb) { rp[nb] = *(const u32x2*)(prow + 16 * nb); kp[nb] = *(const u32x2*)(prow + 512 + 16 * nb); vp[nb] = *(const u32x2*)(prow + 1024 + 16 * nb);
                rp[nb].x &= keep; rp[nb].y &= keep; kp[nb].x &= keep; kp[nb].y &= keep; vp[nb].x &= keep; vp[nb].y &= keep; }
        }
        bf16x8 bfr[5];
#pragma unroll
        for (int ks = 0; ks < 5; ++ks) bfr[ks] = *(const bf16x8*)(lin + fr * PP_LIN_LD + 32 * ks + 8 * g);
        float ss = 0.f;
#pragma unroll
        for (int nb = 0; nb < 4; ++nb) {
            const int cb = 64 * h + 16 * nb + 4 * g;
            const f32x4 muk = *(const f32x4*)(cst + 6 * 512 + cb), kkc = *(const f32x4*)(cst + 2 * 512 + cb);
            const float c0 = bflo(kc[nb].x), c1 = bfhi(kc[nb].x), c2 = bflo(kc[nb].y), c3 = bfhi(kc[nb].y);
            const float p0 = bflo(kp[nb].x), p1 = bfhi(kp[nb].x), p2 = bflo(kp[nb].y), p3 = bfhi(kp[nb].y);
            const float q0 = (c0 + (p0 - c0) * muk.x) * kkc.x, q1 = (c1 + (p1 - c1) * muk.y) * kkc.y, q2 = (c2 + (p2 - c2) * muk.z) * kkc.z, q3 = (c3 + (p3 - c3) * muk.w) * kkc.w;
            ss += (q0 * q0 + q1 * q1) + (q2 * q2 + q3 * q3);
        }
        ss += shfl_xor_l(ss, lane, 16); ss += shfl_xor_l(ss, lane, 32);
        const float kinv = rsqrtf(fmaxf(ss, 1e-24f));
        float br = 0.f, kr = 0.f, rk = 0.f;
        bf16* op = ops + ((size_t)(b * NH + h) * (SEQ / 16) + (t >> 4)) * 6144 + lane * 4;
        bf16* gp = gbuf + ((size_t)tile * NH + h) * 1024 + lane * 4;
#pragma unroll
        for (int nb = 0; nb < 4; ++nb) {
            const int cb = 64 * h + 16 * nb + 4 * g;
            const f32x4 w0c = *(const f32x4*)(cst + 0 * 512 + cb), a0c = *(const f32x4*)(cst + 1 * 512 + cb), kkc = *(const f32x4*)(cst + 2 * 512 + cb), kac = *(const f32x4*)(cst + 3 * 512 + cb);
            const f32x4 rkc = *(const f32x4*)(cst + 4 * 512 + cb), mur = *(const f32x4*)(cst + 5 * 512 + cb), muv = *(const f32x4*)(cst + 7 * 512 + cb);
            const f32x4 muk = *(const f32x4*)(cst + 6 * 512 + cb);
            const pg8::f32x4 z0 = {0.f, 0.f, 0.f, 0.f};
            const pg8::f32x4 zw = __builtin_amdgcn_mfma_f32_16x16x32_bf16(wfr[nb], bfr[0], z0, 0, 0, 0);
            const pg8::f32x4 za = __builtin_amdgcn_mfma_f32_16x16x32_bf16(afr[nb], bfr[1], z0, 0, 0, 0);
            pg8::f32x4 gg = z0;
#pragma unroll
            for (int ks = 0; ks < 3; ++ks) gg = __builtin_amdgcn_mfma_f32_16x16x32_bf16(*(const bf16x8*)(lds + PP_GFR + ((((h * 3 + ks) * 4 + nb) * 64 + lane) * 16)), bfr[2 + ks], gg, 0, 0, 0);
            float o_um[4], o_wr[4], o_a[4], o_b[4], o_k[4], o_v[4], o_g[4];
#pragma unroll
            for (int r4 = 0; r4 < 4; ++r4) {
                const unsigned rcw = r4 < 2 ? rc[nb].x : rc[nb].y, rpw = r4 < 2 ? rp[nb].x : rp[nb].y, vcw = r4 < 2 ? vc[nb].x : vc[nb].y, vpw = r4 < 2 ? vp[nb].x : vp[nb].y;
                const unsigned kcw = r4 < 2 ? kc[nb].x : kc[nb].y, kpw = r4 < 2 ? kp[nb].x : kp[nb].y;
                const float kcur = (r4 & 1) ? bfhi(kcw) : bflo(kcw), kprev = (r4 & 1) ? bfhi(kpw) : bflo(kpw);
                const float rcur = (r4 & 1) ? bfhi(rcw) : bflo(rcw), rprev = (r4 & 1) ? bfhi(rpw) : bflo(rpw), vcur = (r4 & 1) ? bfhi(vcw) : bflo(vcw), vprev = (r4 & 1) ? bfhi(vpw) : bflo(vpw);
                const float r = rcur + (rprev - rcur) * mur[r4], v = vcur + (vprev - vcur) * muv[r4], k = kcur + (kprev - kcur) * muk[r4];
                const float nz = -(w0c[r4] + zw[r4]);
                const float sp = fmaxf(nz, 0.f) + __logf(1.f + __expf(-fabsf(nz)));
                const float e = __expf(-sp - 0.5f);
                const float wdec = __expf(-e), um = 1.f - wdec;
                const float iclr = fast_sigmoid(a0c[r4] + za[r4]);
                const float kk = k * kkc[r4] * kinv;
                const float kh = k * (1.f + (iclr - 1.f) * kac[r4]);
                const float bv = kk * iclr;
                br += bv * r; kr += kh * r; rk += r * kh * rkc[r4];
                o_um[r4] = um; o_wr[r4] = wdec * r; o_a[r4] = -kk; o_b[r4] = bv; o_k[r4] = kh; o_v[r4] = v; o_g[r4] = gg[r4];
            }
            u32x2 w2; if (STORE) {
            w2.x = pk2(o_um[0], o_um[1]); w2.y = pk2(o_um[2], o_um[3]); *(u32x2*)(op + (0 + nb) * 256) = w2;
            w2.x = pk2(o_wr[0], o_wr[1]); w2.y = pk2(o_wr[2], o_wr[3]); *(u32x2*)(op + (4 + nb) * 256) = w2;
            w2.x = pk2(o_a[0], o_a[1]); w2.y = pk2(o_a[2], o_a[3]); *(u32x2*)(op + (8 + nb) * 256) = w2;
            w2.x = pk2(o_b[0], o_b[1]); w2.y = pk2(o_b[2], o_b[3]); *(u32x2*)(op + (12 + nb) * 256) = w2;
            w2.x = pk2(o_k[0], o_k[1]); w2.y = pk2(o_k[2], o_k[3]); *(u32x2*)(op + (16 + nb) * 256) = w2;
            w2.x = pk2(o_v[0], o_v[1]); w2.y = pk2(o_v[2], o_v[3]); *(u32x2*)(op + (20 + nb) * 256) = w2;
            w2.x = pk2(o_g[0], o_g[1]); w2.y = pk2(o_g[2], o_g[3]); *(u32x2*)(gp + nb * 256) = w2; }
            else { asm volatile("" :: "v"(o_um[0] + o_wr[1] + o_a[2] + o_b[3] + o_k[0] + o_v[1] + o_g[2])); }
        }
        br += shfl_xor_l(br, lane, 16); br += shfl_xor_l(br, lane, 32);
        kr += shfl_xor_l(kr, lane, 16); kr += shfl_xor_l(kr, lane, 32);
        rk += shfl_xor_l(rk, lane, 16); rk += shfl_xor_l(rk, lane, 32);
        if (!STORE) { asm volatile("" :: "v"(br + kr + rk)); } else if (g == 0) { f32x4 s4 = {br, kr, rk, 0.f}; *(f32x4*)(scal + ((size_t)(b * NH + h) * SEQ + t) * 4) = s4; }
        __syncthreads();
    }
}

constexpr int SC_TC = 32, SC_STEP = 340, SC_BUF = SC_TC * SC_STEP;
struct StepOps { f32x4 W, AW0, AW1, B, K; float v; f32x2 sc; };
__device__ __forceinline__ void sc_load(StepOps& o, const float* p, int wq, int row16) {
    o.W = *(const f32x4*)(p + wq); o.AW0 = *(const f32x4*)(p + 64 + wq); o.AW1 = *(const f32x4*)(p + 128 + wq); o.B = *(const f32x4*)(p + 192 + wq); o.K = *(const f32x4*)(p + 256 + wq);
    o.v = p[320 + row16]; o.sc = *(const f32x2*)(p + 336);
}
__device__ __forceinline__ void scan_phase(const Params& P, float* lds, int tid, int wave, int lane) {
    const int BIDX = bidx(), GDIMX = gdimx();
    const bf16* ops = (const bf16*)(P.ws + WS_OPS); const float* scal = (const float*)(P.ws + WS_SCAL); float* yraw = (float*)(P.ws + WS_YRAW);
    float* buf0 = lds; float* ybuf0 = lds + 2 * SC_BUF;
    const int vcu = (GDIMX % 8 == 0) ? (BIDX % 8) * (GDIMX / 8) + BIDX / 8 : BIDX;
    for (int unit = vcu; unit < 256; unit += GDIMX) {
        const int bh = unit >> 2, rq = unit & 3, b = bh >> 3, hh = bh & 7;
        const bool loader = wave >= 4; const int ltid = tid - 256;
        const int ks = lane & 15, row16 = (wave & 3) * 4 + (lane >> 4), wq = 4 * ks;
        float s0 = 0.f, s1 = 0.f, s2 = 0.f, s3 = 0.f;
        const int ydelta = row16 * 8 + (ks & 7);
        u32x4 ld_[6]; f32x4 sc4_ = {0.f, 0.f, 0.f, 0.f};
#define SC_LOAD(c) do { const int t0_ = (c) * SC_TC; const bf16* src_ = ops + ((size_t)bh * (SEQ / 16) + (t0_ >> 4)) * 6144; \
            _Pragma("unroll") for (int i = 0; i < 6; ++i) ld_[i] = *(const u32x4*)(src_ + (size_t)(ltid + 256 * i) * 8); \
            if (ltid < 32) sc4_ = *(const f32x4*)(scal + ((size_t)bh * SEQ + t0_ + ltid) * 4); } while (0)
#define SC_WRITE(c) do { float* bufw = buf0 + ((c) & 1) * SC_BUF; \
            _Pragma("unroll") for (int i = 0; i < 6; ++i) { const int id = ltid + 256 * i, tl = id / 768, rem = id - tl * 768, vec = rem >> 7, r2 = rem & 127, nb = r2 >> 5, lp = r2 & 31; \
                const int tk = tl * 16 + ((2 * lp) & 15), gq = (2 * lp) >> 4;        \
                f32x4 lo_ = {bflo(ld_[i].x), bfhi(ld_[i].x), bflo(ld_[i].y), bfhi(ld_[i].y)}, hi_ = {bflo(ld_[i].z), bfhi(ld_[i].z), bflo(ld_[i].w), bfhi(ld_[i].w)}; \
                if (vec == 0) { lo_ = 1.f - lo_; hi_ = 1.f - hi_; } \
                if (vec == 1 || vec == 2) { float* d_ = bufw + tk * SC_STEP + 64 + 4 * (4 * nb + gq) + (vec == 1 ? 1 : 0);        \
                    d_[0] = lo_.x; d_[2] = lo_.y; d_[64] = lo_.z; d_[66] = lo_.w; d_ += SC_STEP; d_[0] = hi_.x; d_[2] = hi_.y; d_[64] = hi_.z; d_[66] = hi_.w; } \
                else if (vec < 5) { float* d_ = bufw + tk * SC_STEP + vec * 64 + 16 * nb + 4 * gq; *(f32x4*)d_ = lo_; *(f32x4*)(d_ + SC_STEP) = hi_; } \
                else if (nb == rq) { float* d_ = bufw + tk * SC_STEP + 320 + 4 * gq; *(f32x4*)d_ = lo_; *(f32x4*)(d_ + SC_STEP) = hi_; } } \
            if (ltid < 32) { f32x2 s2_ = {sc4_.x * 0.125f, sc4_.y * 0.125f}; *(f32x2*)(bufw + ltid * SC_STEP + 336) = s2_; } } while (0)
#define SC_YOUT(c) do { const float* yb_ = ybuf0 + ((c) & 1) * (SC_TC * 128); const int t0_ = (c) * SC_TC; \
            _Pragma("unroll") for (int i = 0; i < 2; ++i) { const int id = ltid + 256 * i; \
                const f32x4 pa_ = *(const f32x4*)(yb_ + id * 8), pb_ = *(const f32x4*)(yb_ + id * 8 + 4);        \
                yraw[((size_t)(bh * 4 + rq) * SEQ + t0_) * 16 + id] = ((pa_.x + pa_.y) + (pa_.z + pa_.w)) + ((pb_.x + pb_.y) + (pb_.z + pb_.w)); } } while (0)
        constexpr int NCH = SEQ / SC_TC;
        if (loader) { SC_LOAD(0); SC_WRITE(0); SC_LOAD(1); }
        __syncthreads();
        for (int c = 0; c < NCH; ++c) {
            if (loader) {
                if (c + 1 < NCH) SC_WRITE(c + 1);
                if (c + 2 < NCH) SC_LOAD(c + 2);
                if (c > 0) SC_YOUT(c - 1);
            } else {
                __builtin_amdgcn_s_setprio(1);
                const float* bufr = buf0 + (c & 1) * SC_BUF; float* ybl = ybuf0 + (c & 1) * (SC_TC * 128) + ydelta;
                StepOps cur, nxt;
                sc_load(cur, bufr, wq, row16);
#pragma unroll 8
                for (int st = 0; st < SC_TC; ++st) {
                    sc_load(nxt, bufr + (st + 1 < SC_TC ? st + 1 : st) * SC_STEP, wq, row16);
                    f32x2 dd = (f32x2){cur.AW0.x, cur.AW0.y} * s0;
                    dd += (f32x2){cur.AW0.z, cur.AW0.w} * s1; dd += (f32x2){cur.AW1.x, cur.AW1.y} * s2; dd += (f32x2){cur.AW1.z, cur.AW1.w} * s3;
                    float da = dd.x, dy = dd.y;
                    da = row16_sum(da); dy += dpp_f<0x128>(dy);
                    s0 = s0 * cur.W.x + da * cur.B.x + cur.v * cur.K.x;
                    s1 = s1 * cur.W.y + da * cur.B.y + cur.v * cur.K.y;
                    s2 = s2 * cur.W.z + da * cur.B.z + cur.v * cur.K.z;
                    s3 = s3 * cur.W.w + da * cur.B.w + cur.v * cur.K.w;
                    const float y = dy + da * cur.sc.x + cur.v * cur.sc.y;
                    ybl[st * 128] = y;
                    cur = nxt;
                }
                __builtin_amdgcn_s_setprio(0);
            }
            __syncthreads();
        }
        if (loader) SC_YOUT(NCH - 1);
        __syncthreads();
#undef SC_LOAD
#undef SC_WRITE
#undef SC_YOUT
    }
}

__device__ __forceinline__ void post_phase(const Params& P, int idx, unsigned char* lds, int gw, int ngw, int wave, int lane) {
    const float* yraw = (const float*)(P.ws + WS_YRAW); const bf16* ops = (const bf16*)(P.ws + WS_OPS); const float* scal = (const float*)(P.ws + WS_SCAL);
    const bf16* gbuf = (const bf16*)(P.ws + WS_GBUF); bf16* ycat = (bf16*)(P.ws + WS_H);
    const int fr = lane & 15, g = lane >> 4;
    unsigned char* stg = lds + wave * 2304;
    for (int task = gw; task < (MTOK / 16) * NH; task += ngw) {
        const int tile = task >> 3, h = task & 7, m = tile * 16 + fr, t = m & (SEQ - 1), b = m >> 12, bh = b * NH + h;
        f32x4 y[4], lw[4], lb[4]; u32x2 vv[4], gg[4];
#pragma unroll
        for (int nb = 0; nb < 4; ++nb) {
            y[nb] = *(const f32x4*)(yraw + ((size_t)(bh * 4 + nb) * SEQ + t) * 16 + 4 * g);
            vv[nb] = *(const u32x2*)(ops + ((size_t)bh * (SEQ / 16) + (t >> 4)) * 6144 + (20 + nb) * 256 + lane * 4);
            gg[nb] = *(const u32x2*)(gbuf + ((size_t)tile * NH + h) * 1024 + nb * 256 + lane * 4);
            lw[nb] = *(const f32x4*)(P.in[I_LNW] + idx * 512 + h * 64 + 16 * nb + 4 * g);
            lb[nb] = *(const f32x4*)(P.in[I_LNB] + idx * 512 + h * 64 + 16 * nb + 4 * g);
        }
        const float rk = scal[((size_t)bh * SEQ + t) * 4 + 2];
        float sm = 0.f;
#pragma unroll
        for (int nb = 0; nb < 4; ++nb) sm += (y[nb].x + y[nb].y) + (y[nb].z + y[nb].w);
        sm += shfl_xor_l(sm, lane, 16); sm += shfl_xor_l(sm, lane, 32);
        const float mean = sm * (1.f / 64.f);
        float sv = 0.f;
#pragma unroll
        for (int nb = 0; nb < 4; ++nb) { y[nb] = y[nb] - mean; sv += (y[nb].x * y[nb].x + y[nb].y * y[nb].y) + (y[nb].z * y[nb].z + y[nb].w * y[nb].w); }
        sv += shfl_xor_l(sv, lane, 16); sv += shfl_xor_l(sv, lane, 32);
        const float rstd = rsqrtf(sv * (1.f / 64.f) + GN_EPS);
#pragma unroll
        for (int nb = 0; nb < 4; ++nb) {
            const float v0 = bflo(vv[nb].x), v1 = bfhi(vv[nb].x), v2 = bflo(vv[nb].y), v3 = bfhi(vv[nb].y);
            const float g0 = bflo(gg[nb].x), g1 = bfhi(gg[nb].x), g2 = bflo(gg[nb].y), g3 = bfhi(gg[nb].y);
            const float o0 = (y[nb].x * rstd * lw[nb].x + lb[nb].x + rk * v0) * g0, o1 = (y[nb].y * rstd * lw[nb].y + lb[nb].y + rk * v1) * g1;
            const float o2 = (y[nb].z * rstd * lw[nb].z + lb[nb].z + rk * v2) * g2, o3 = (y[nb].w * rstd * lw[nb].w + lb[nb].w + rk * v3) * g3;
            u32x2 w; w.x = pk2(o0, o1); w.y = pk2(o2, o3);
            *(u32x2*)(stg + fr * 144 + (16 * nb + 4 * g) * 2) = w;
        }
        asm volatile("s_waitcnt lgkmcnt(0)" ::: "memory");
#pragma unroll
        for (int i = 0; i < 2; ++i) { const int rowi = 8 * i + (lane >> 3), ch = lane & 7;
            const u32x4 w = *(const u32x4*)(stg + rowi * 144 + ch * 16);
            *(u32x4*)(ycat + (size_t)(tile * 16 + rowi) * DM + 512 + h * 64 + ch * 8) = w; }
        asm volatile("s_waitcnt lgkmcnt(0)" ::: "memory");
    }
}

__device__ __forceinline__ void mla_norm_phase(const Params& P, int idx, int gw, int ngw, int lane) {
    const bf16* podd = (const bf16*)(P.ws + WS_PODD); bf16* cqn = (bf16*)(P.ws + WS_CQN); bf16* ckvn = (bf16*)(P.ws + WS_CKVN); bf16* kpe = (bf16*)(P.ws + WS_KPE);
    float gq[8], gk[8];
    const int lq = lane < 48 ? lane : 0, lk = lane < 32 ? lane : 0, lp = lane < 8 ? lane : 0;
#pragma unroll
    for (int e = 0; e < 8; ++e) { gq[e] = P.in[I_QAN][idx * QRANK + 8 * lq + e]; gk[e] = P.in[I_KVAN][idx * KVRANK + 8 * lk + e]; }
    for (int m0 = 2 * gw; m0 < MTOK; m0 += 2 * ngw) {
        u32x4 wq[2], wk[2], wp[2];
#pragma unroll
        for (int u = 0; u < 2; ++u) { const bf16* row = podd + (size_t)(m0 + u) * PODD_LD;
            wq[u] = *(const u32x4*)(row + 8 * lq); wk[u] = *(const u32x4*)(row + QRANK + 8 * lk); wp[u] = *(const u32x4*)(row + QRANK + KVRANK + 8 * lp); }
#pragma unroll
        for (int u = 0; u < 2; ++u) { const int m = m0 + u;
            float q[8], k[8]; unpack8(wq[u], q); unpack8(wk[u], k);
            float sq = 0.f, sk = 0.f;
#pragma unroll
            for (int e = 0; e < 8; ++e) { sq += q[e] * q[e]; sk += k[e] * k[e]; }
            sq = lane < 48 ? sq : 0.f; sk = lane < 32 ? sk : 0.f;
            const float rq = rsqrtf(wave_sum(sq) * (1.f / QRANK) + NORM_EPS), rk = rsqrtf(wave_sum(sk) * (1.f / KVRANK) + NORM_EPS);
#pragma unroll
            for (int e = 0; e < 8; ++e) { q[e] *= rq * gq[e]; k[e] *= rk * gk[e]; }
            if (lane < 48) *(u32x4*)(cqn + (size_t)m * QRANK + 8 * lane) = pack8(q);
            if (lane < 32) *(u32x4*)(ckvn + (size_t)m * KVRANK + 8 * lane) = pack8(k);
            if (lane < 8) *(u32x4*)(kpe + (size_t)m * 64 + 8 * lane) = wp[u]; }
    }
}

constexpr float ATTN_C2 = 0.07216878364870322f * 1.4426950408889634f;
__device__ __forceinline__ void qk_prep_phase(const Params& P, int idx, unsigned char* lds, int gw, int ngw, int wave, int lane) {
    bf16* qb = (bf16*)(P.ws + WS_QB); const bf16* knope = (const bf16*)(P.ws + WS_KNOPE); const bf16* kpe = (const bf16*)(P.ws + WS_KPE); bf16* kf = (bf16*)(P.ws + WS_KF);
    const int* pos = (const int*)P.in[I_POS];
    const int h = lane >> 3, s = lane & 7;
    float qg[24], kg[24];
#pragma unroll
    for (int e = 0; e < 16; ++e) { qg[e] = P.in[I_QN][idx * QKD + 16 * s + e]; kg[e] = P.in[I_KN][idx * QKD + 16 * s + e]; }
#pragma unroll
    for (int e = 0; e < 8; ++e) { qg[16 + e] = P.in[I_QN][idx * QKD + 128 + 8 * s + e]; kg[16 + e] = P.in[I_KN][idx * QKD + 128 + 8 * s + e]; }
    float* cst = (float*)(lds + wave * 256);
    const float inv_freq = powf(10000.f, -(float)(lane & 31) * (1.f / 32.f));
    const float sgn = s < 4 ? -1.f : 1.f;
    for (int m = gw; m < MTOK; m += ngw) {
        bf16* qrow = qb + (size_t)m * 1536 + h * QKD; const bf16* krow = knope + (size_t)m * 1024 + h * 128;
        const u32x4 qa = *(const u32x4*)(qrow + 16 * s), qc = *(const u32x4*)(qrow + 16 * s + 8), qr = *(const u32x4*)(qrow + 128 + 8 * s);
        const u32x4 ka = *(const u32x4*)(krow + 16 * s), kc = *(const u32x4*)(krow + 16 * s + 8), kr = *(const u32x4*)(kpe + (size_t)m * 64 + 8 * s);
        {
            const float ang = (float)pos[m] * inv_freq;
            const float n = rintf(ang * 0.15915494309189535f);
            float rr = fmaf(-n, 6.28318548202514648f, ang); rr = fmaf(-n, -1.7484555e-7f, rr);
            if (lane < 32) { cst[lane] = __cosf(rr); cst[32 + lane] = __sinf(rr); }
        }
        asm volatile("s_waitcnt lgkmcnt(0)" ::: "memory");
        float cs[8], sn[8];
        { const f32x4 c0 = *(const f32x4*)(cst + 8 * (s & 3)), c1 = *(const f32x4*)(cst + 8 * (s & 3) + 4), s0 = *(const f32x4*)(cst + 32 + 8 * (s & 3)), s1 = *(const f32x4*)(cst + 32 + 8 * (s & 3) + 4);
          cs[0] = c0.x; cs[1] = c0.y; cs[2] = c0.z; cs[3] = c0.w; cs[4] = c1.x; cs[5] = c1.y; cs[6] = c1.z; cs[7] = c1.w;
          sn[0] = s0.x; sn[1] = s0.y; sn[2] = s0.z; sn[3] = s0.w; sn[4] = s1.x; sn[5] = s1.y; sn[6] = s1.z; sn[7] = s1.w; }
#pragma unroll
        for (int which = 0; which < 2; ++which) {
            float x0[8], x1[8], xr[8];
            unpack8(which ? ka : qa, x0); unpack8(which ? kc : qc, x1); unpack8(which ? kr : qr, xr);
            float ss = 0.f;
#pragma unroll
            for (int e = 0; e < 8; ++e) ss += x0[e] * x0[e] + x1[e] * x1[e] + xr[e] * xr[e];
            ss += shfl_xor_l(ss, lane, 1); ss += shfl_xor_l(ss, lane, 2); ss += shfl_xor_l(ss, lane, 4);
            const float rn = rsqrtf(ss * (1.f / QKD) + NORM_EPS) * (which ? 1.f : ATTN_C2);
            float o0[8], o1[8], orr[8];
#pragma unroll
            for (int e = 0; e < 8; ++e) {
                const float g0 = which ? kg[e] : qg[e], g1 = which ? kg[8 + e] : qg[8 + e], g2 = which ? kg[16 + e] : qg[16 + e];
                o0[e] = x0[e] * rn * g0; o1[e] = x1[e] * rn * g1;
                const float val = xr[e] * rn * g2;
                const float par = shfl_xor_l(val, lane, 4);
                orr[e] = val * cs[e] + sgn * par * sn[e];
            }
            bf16* orow = which ? kf + (size_t)m * 1536 + h * QKD : qrow;
            *(u32x4*)(orow + 16 * s) = pack8(o0); *(u32x4*)(orow + 16 * s + 8) = pack8(o1); *(u32x4*)(orow + 128 + 8 * s) = pack8(orr);
        }
    }
}

constexpr int AT_KB = 64 * QKD * 2, AT_VB = VD * 64 * 2;
__device__ __forceinline__ void attn_phase(const Params& P, unsigned char* lds, int tid, int wave, int lane) {
    const int BIDX = bidx(), GDIMX = gdimx();
    const bf16* Q = (const bf16*)(P.ws + WS_QB); const bf16* Kf = (const bf16*)(P.ws + WS_KF); const bf16* VT = (const bf16*)(P.ws + WS_VT); bf16* O = (bf16*)(P.ws + WS_H);
    const int fr = lane & 15, g = lane >> 4;
    LAS unsigned char* ldsl = (LAS unsigned char*)lds;
    const int vcu = (GDIMX % 8 == 0) ? (BIDX % 8) * (GDIMX / 8) + BIDX / 8 : BIDX;
    for (int unit = vcu; unit < 1024; unit += GDIMX) {
        const int v = unit & 255, ui = unit >> 8, bh = v >> 2, s = v & 3;
        const int qb = (ui == 0) ? s : (ui == 1) ? 7 - s : (ui == 2) ? 8 + s : 15 - s;
        const int b = bh >> 3, h = bh & 7, q0 = qb * 256, NT = (q0 + 256) / 64;
        const size_t bT = (size_t)b * SEQ;
        bf16x8 qf[2][6];
#pragma unroll
        for (int qi = 0; qi < 2; ++qi)
#pragma unroll
            for (int ks = 0; ks < 6; ++ks) qf[qi][ks] = *(const bf16x8*)(Q + (bT + q0 + 32 * wave + 16 * qi + fr) * 1536 + h * QKD + 32 * ks + 8 * g);
        pg8::f32x4 oacc[8][2];
#pragma unroll
        for (int db = 0; db < 8; ++db) { oacc[db][0] = (pg8::f32x4){0.f, 0.f, 0.f, 0.f}; oacc[db][1] = (pg8::f32x4){0.f, 0.f, 0.f, 0.f}; }
        float mrun[2] = {-1e30f, -1e30f}, lsum[2] = {0.f, 0.f};
#define AT_KDMA(j, bufi) do { \
            _Pragma("unroll") for (int i = 0; i < 3; ++i) { const int blk = wave + 8 * i, kb_ = blk / 6, ks_ = blk - kb_ * 6; \
                __builtin_amdgcn_global_load_lds((const unsigned*)(Kf + (bT + 64 * (j) + 16 * kb_ + fr) * 1536 + h * QKD + 32 * ks_ + 8 * g), (LAS unsigned*)(ldsl + (bufi) * AT_KB + blk * 1024), 16, 0, 0); } } while (0)
#define AT_VDMA(j, bufi) do { \
            _Pragma("unroll") for (int i = 0; i < 2; ++i) { const int blk = wave + 8 * i; \
                __builtin_amdgcn_global_load_lds((const unsigned*)(VT + (size_t)(h * VD + 16 * (blk >> 1) + fr) * MTOK + bT + 64 * (j) + 32 * (blk & 1) + 8 * g), (LAS unsigned*)(ldsl + 2 * AT_KB + (bufi) * AT_VB + blk * 1024), 16, 0, 0); } } while (0)
#define AT_VFRAG(dst, vb, db) do { \
            dst[0] = *(const u32x4*)((vb) + ((((db) * 2 + 0) * 4 + g) * 16 + fr) * 16); dst[1] = *(const u32x4*)((vb) + ((((db) * 2 + 1) * 4 + g) * 16 + fr) * 16); } while (0)
#define AT_PV(vb) do { u32x4 vfr_[2][2]; AT_VFRAG(vfr_[0], vb, 0); \
            _Pragma("unroll") for (int db = 0; db < 8; ++db) { \
                if (db + 1 < 8) AT_VFRAG(vfr_[(db + 1) & 1], vb, db + 1); \
                __builtin_amdgcn_sched_barrier(0); \
                _Pragma("unroll") for (int k2 = 0; k2 < 2; ++k2) { \
                    const bf16x8 vfrag_ = __builtin_bit_cast(bf16x8, vfr_[db & 1][k2]); \
                    oacc[db][0] = __builtin_amdgcn_mfma_f32_16x16x32_bf16(vfrag_, pf[0][k2], oacc[db][0], 0, 0, 0); \
                    oacc[db][1] = __builtin_amdgcn_mfma_f32_16x16x32_bf16(vfrag_, pf[1][k2], oacc[db][1], 0, 0, 0); } \
                __builtin_amdgcn_sched_barrier(0); } } while (0)
        const bool lag = wave >= 4; bool pend = false;
        bf16x8 pf[2][2];
#pragma unroll
        for (int qi = 0; qi < 2; ++qi) { pf[qi][0] = (bf16x8){0, 0, 0, 0, 0, 0, 0, 0}; pf[qi][1] = (bf16x8){0, 0, 0, 0, 0, 0, 0, 0}; }
        AT_KDMA(0, 0);
        AT_VDMA(0, 0);
        asm volatile("s_waitcnt vmcnt(0) lgkmcnt(0)" ::: "memory");
        __syncthreads();
        int vi = 0, vprev = 2, vnext = 1;
        for (int j = 0; j < NT; ++j) {
            if (j + 1 < NT) { AT_KDMA(j + 1, (j + 1) & 1); AT_VDMA(j + 1, vnext); }
            const unsigned char* kb = lds + (j & 1) * AT_KB; const unsigned char* vb = lds + 2 * AT_KB + vi * AT_VB;
            if (pend) { const unsigned char* vbp = lds + 2 * AT_KB + vprev * AT_VB; AT_PV(vbp); pend = false; }
            if (64 * j <= q0 + 32 * wave + 31) {
                pg8::f32x4 sacc[4][2];
#pragma unroll
                for (int kb4 = 0; kb4 < 4; ++kb4) { sacc[kb4][0] = (pg8::f32x4){0.f, 0.f, 0.f, 0.f}; sacc[kb4][1] = (pg8::f32x4){0.f, 0.f, 0.f, 0.f}; }
                bf16x8 kfr[2][4];
#pragma unroll
                for (int kb4 = 0; kb4 < 4; ++kb4) kfr[0][kb4] = *(const bf16x8*)(kb + ((((kb4 * 6 + 0) * 4 + g) * 16 + fr) * 16));
#pragma unroll
                for (int ks = 0; ks < 6; ++ks) {
                    if (ks + 1 < 6) {
#pragma unroll
                        for (int kb4 = 0; kb4 < 4; ++kb4) kfr[(ks + 1) & 1][kb4] = *(const bf16x8*)(kb + ((((kb4 * 6 + ks + 1) * 4 + g) * 16 + fr) * 16));
                    }
                    __builtin_amdgcn_sched_barrier(0);
#pragma unroll
                    for (int kb4 = 0; kb4 < 4; ++kb4) {
                        sacc[kb4][0] = __builtin_amdgcn_mfma_f32_16x16x32_bf16(kfr[ks & 1][kb4], qf[0][ks], sacc[kb4][0], 0, 0, 0);
                        sacc[kb4][1] = __builtin_amdgcn_mfma_f32_16x16x32_bf16(kfr[ks & 1][kb4], qf[1][ks], sacc[kb4][1], 0, 0, 0);
                    }
                    __builtin_amdgcn_sched_barrier(0);
                }
                if (j >= NT - 4) {
#pragma unroll
                    for (int qi = 0; qi < 2; ++qi) { const int qpos = q0 + 32 * wave + 16 * qi + fr;
#pragma unroll
                        for (int kb4 = 0; kb4 < 4; ++kb4)
#pragma unroll
                            for (int r = 0; r < 4; ++r) if (64 * j + 16 * kb4 + 4 * g + r > qpos) sacc[kb4][qi][r] = -1e30f; }
                }
#pragma unroll
                for (int qi = 0; qi < 2; ++qi) {
                    float mx = -1e30f;
#pragma unroll
                    for (int kb4 = 0; kb4 < 4; ++kb4)
#pragma unroll
                        for (int r = 0; r < 4; ++r) mx = fmaxf(mx, sacc[kb4][qi][r]);
                    mx = fmaxf(mx, shfl_xor_l(mx, lane, 16)); mx = fmaxf(mx, shfl_xor_l(mx, lane, 32));
                    const float mnew = fmaxf(mrun[qi], mx);
                    const float alpha = __builtin_amdgcn_exp2f(mrun[qi] - mnew);
                    mrun[qi] = mnew;
                    float ps = 0.f;
#pragma unroll
                    for (int kb4 = 0; kb4 < 4; ++kb4)
#pragma unroll
                        for (int r = 0; r < 4; ++r) { const float p = __builtin_amdgcn_exp2f(sacc[kb4][qi][r] - mnew); sacc[kb4][qi][r] = p; ps += p; }
                    lsum[qi] = lsum[qi] * alpha + ps;
#pragma unroll
                    for (int db = 0; db < 8; ++db) { oacc[db][qi][0] *= alpha; oacc[db][qi][1] *= alpha; oacc[db][qi][2] *= alpha; oacc[db][qi][3] *= alpha; }
#pragma unroll
                    for (int k2 = 0; k2 < 2; ++k2) {
                        u32x4 w; w.x = pk2(sacc[2 * k2][qi][0], sacc[2 * k2][qi][1]); w.y = pk2(sacc[2 * k2][qi][2], sacc[2 * k2][qi][3]);
                        w.z = pk2(sacc[2 * k2 + 1][qi][0], sacc[2 * k2 + 1][qi][1]); w.w = pk2(sacc[2 * k2 + 1][qi][2], sacc[2 * k2 + 1][qi][3]);
                        pf[qi][k2] = __builtin_bit_cast(bf16x8, w);
                    }
                }
                if (lag) pend = true; else AT_PV(vb);
            }
            asm volatile("s_waitcnt vmcnt(0) lgkmcnt(0)" ::: "memory");
            __syncthreads();
            { const int t_ = vprev; vprev = vi; vi = vnext; vnext = t_; }
        }
        if (pend) { const unsigned char* vbp = lds + 2 * AT_KB + vprev * AT_VB; AT_PV(vbp); }
#pragma unroll
        for (int qi = 0; qi < 2; ++qi) {
            float l = lsum[qi]; l += shfl_xor_l(l, lane, 16); l += shfl_xor_l(l, lane, 32);
            const float inv = 1.f / l;
            bf16* orow = O + (bT + q0 + 32 * wave + 16 * qi + fr) * DM + h * VD + 4 * g;
#pragma unroll
            for (int db = 0; db < 8; ++db) { u32x2 w; w.x = pk2(oacc[db][qi][0] * inv, oacc[db][qi][1] * inv); w.y = pk2(oacc[db][qi][2] * inv, oacc[db][qi][3] * inv); *(u32x2*)(orow + 16 * db) = w; }
        }
        asm volatile("s_waitcnt lgkmcnt(0)" ::: "memory");
        __syncthreads();
#undef AT_VFRAG
#undef AT_PV
#undef AT_KDMA
#undef AT_VDMA
    }
}

#define XB_TMO      128
#define XB_XCNT(j)  (256  + 64 * (j))
#define XB_XSUB(j)  (1280 + 64 * (j))
#define XB_XGEN(j)  (2304 + 64 * (j))
#define XB_TOP      3328
#define XB_TOPGEN   3392
#define XCD_BAR_WORDS 3456
#define XB_SPIN_CAP (1u << 18)

__device__ __forceinline__ unsigned xb_ld(unsigned* p)              { return __hip_atomic_load(p, __ATOMIC_RELAXED, __HIP_MEMORY_SCOPE_AGENT); }
__device__ __forceinline__ unsigned xb_add(unsigned* p, unsigned v) { return __hip_atomic_fetch_add(p, v, __ATOMIC_RELAXED, __HIP_MEMORY_SCOPE_AGENT); }
__device__ __forceinline__ unsigned xb_xcc_id() { return (unsigned)__builtin_amdgcn_s_getreg((3 << 11) | 20) & 0xFu; }
#define XB_SPIN(cond, bar) do { unsigned _sp = 0; while (cond) { __builtin_amdgcn_s_sleep(1); \
    if ((++_sp & 255u) == 0u) { if (xb_ld(&(bar)[XB_TMO])) break; if (_sp > XB_SPIN_CAP) { atomicAdd(&(bar)[XB_TMO], 1u); break; } } } } while (0)

struct XcdBarrier {
    unsigned* bar; unsigned x;
    volatile LAS unsigned* st;
};

__device__ __forceinline__ XcdBarrier xcd_barrier_post(unsigned* bar, volatile LAS unsigned* st) {
    XcdBarrier b; b.bar = bar; b.x = xb_xcc_id(); b.st = st;
    if (threadIdx.x == 0) (void)xb_add(&bar[XB_XCNT(b.x)], 1u);
    return b;
}
__device__ __forceinline__ void xcd_barrier_complete(unsigned* bar, unsigned x, unsigned& nloc, unsigned& nx) {
    const unsigned G = gridDim.x * gridDim.y * gridDim.z;
    unsigned sum, cnt, mine, sp = 0u;
    for (;;) {
        sum = 0u; cnt = 0u; mine = 0u;
#pragma unroll
        for (unsigned j = 0; j < 16; ++j) { const unsigned c = xb_ld(&bar[XB_XCNT(j)]); sum += c; cnt += (c > 0u) ? 1u : 0u; mine = (j == x) ? c : mine; }
        if (sum == G) break;
        __builtin_amdgcn_s_sleep(1);
        if ((++sp & 255u) == 0u) { if (xb_ld(&bar[XB_TMO])) break; if (sp > XB_SPIN_CAP) { atomicAdd(&bar[XB_TMO], 1u); break; } }
    }
    nloc = mine > 0u ? mine : 1u; nx = cnt > 0u ? cnt : 1u;
}

__device__ __forceinline__ void xcd_barrier(const XcdBarrier& b) {
    asm volatile("s_waitcnt vmcnt(0)" ::: "memory");
    __syncthreads();
    if (threadIdx.x == 0) {
        unsigned* bar = b.bar;
        __builtin_amdgcn_s_waitcnt(0);
        unsigned nloc = b.st[0], nx = b.st[1];
        if (nloc == 0u) { xcd_barrier_complete(bar, b.x, nloc, nx); b.st[0] = nloc; b.st[1] = nx; }
        const unsigned old = xb_add(&bar[XB_XSUB(b.x)], 1u);
        const unsigned gen = old / nloc;
        if (old + 1u == (gen + 1u) * nloc) {
            __builtin_amdgcn_fence(__ATOMIC_RELEASE, "agent");
            asm volatile("s_waitcnt vmcnt(0)" ::: "memory");
            const unsigned og = xb_add(&bar[XB_TOP], 1u);
            const unsigned tg = og / nx;
            if (og + 1u == (tg + 1u) * nx) xb_add(&bar[XB_TOPGEN], 1u);
            else XB_SPIN(xb_ld(&bar[XB_TOPGEN]) == tg, bar);
            __builtin_amdgcn_fence(__ATOMIC_ACQUIRE, "agent");
            xb_add(&bar[XB_XGEN(b.x)], 1u);
            asm volatile("s_waitcnt vmcnt(0)" ::: "memory");
        } else {
            XB_SPIN(xb_ld(&bar[XB_XGEN(b.x)]) == gen, bar);
            __builtin_amdgcn_fence(__ATOMIC_ACQUIRE, "agent");
            asm volatile("s_waitcnt vmcnt(0)" ::: "memory");
        }
    }
    __syncthreads();
}

#define GEMM_ARGS true, true
#ifndef REP_SCAN
#define REP_SCAN 1
#endif
#ifndef REP_ATTN
#define REP_ATTN 1
#endif
#ifndef REP_PREP
#define REP_PREP 1
#endif
#ifndef REP_SMALL
#define REP_SMALL 1
#endif
#define WSP() ({ size_t o_ = 0; asm volatile("" : "+s"(o_)); P.ws + o_; })
#define SYNC() do { XcdBarrier xb_; xb_.bar = (unsigned*)(WSP() + WS_CTL); xb_.x = xb_xcc_id(); xb_.st = (volatile LAS unsigned*)(lds_raw + LDS_MISC); xcd_barrier(xb_); asm volatile("" : "+s"(layer), "+s"(ff)); } while (0)
#define SYNC_CG() do { grid.sync(); asm volatile("" : "+s"(layer), "+s"(ff)); } while (0)
#define TIDS() int tid_ = threadIdx.x; asm volatile("" : "+v"(tid_)); const int tid = tid_, lane = tid & 63, wave = __builtin_amdgcn_readfirstlane(tid >> 6); const int G = gdimx(), bidx_ = bidx(), gw = bidx_ * NWAVES + wave, ngw = G * NWAVES; (void)bidx_; (void)lane; (void)gw; (void)ngw; (void)G
__global__ void __launch_bounds__(NTHR, 2) mega_fwd(Params P) {
    extern __shared__ __attribute__((aligned(16))) unsigned char lds_raw[];
    cg::grid_group grid = cg::this_grid();
    int ff = 0;
    if (threadIdx.x < 4) ((volatile LAS unsigned*)(lds_raw + LDS_MISC))[threadIdx.x] = 0u;
    __syncthreads();
    (void)xcd_barrier_post((unsigned*)(P.ws + WS_CTL), (volatile LAS unsigned*)(lds_raw + LDS_MISC));
#pragma unroll 1
    for (int layer = 0; layer < DEPTH; ++layer) {
        {
            TIDS(); unsigned char* ws = WSP();
#ifndef NO_CONV_W
            convert_layer_weights(P, layer, (float*)(lds_raw + wave * 16384), gw, ngw, lane);
#endif
            rms_phase(layer == 0 ? P.in[I_X] : P.out, layer == 0 ? P.out : nullptr, P.in[I_GAINS] + (size_t)layer * 3 * DM, (bf16*)(ws + WS_H), gw, ngw, lane);
        }
        { int never_ = 0; asm volatile("" : "+s"(never_)); if (never_) SYNC_CG(); }
        SYNC();
#pragma unroll 1
        for (ff = 0; ff < 2; ++ff) {
            if (ff == 1) { TIDS(); unsigned char* ws = WSP(); rms_phase(P.out, nullptr, P.in[I_GAINS] + (size_t)layer * 3 * DM + 2 * DM, (bf16*)(ws + WS_H), gw, ngw, lane); SYNC(); }
            {
                unsigned char* ws = WSP();
                pg8::Gemm g{(const bf16*)(ws + WS_H), (const bf16*)(ws + (ff ? WS_WGU1 : WS_WGU0)), MTOK, 2 * DFF, DM}; pg8::StaticOrder S; S.init(MTOK, 2 * DFF, gdimx(), bidx());
                EpiSwiGLU E{(bf16*)(ws + WS_ACT), DFF};

#ifndef NO_G_GU
pg8::gemm_phase<EpiSwiGLU, pg8::StaticOrder, GEMM_ARGS>((LAS unsigned char*)lds_raw, g, S, E);
#endif

            }
            SYNC();
            {
                unsigned char* ws = WSP();
                pg8::Gemm g{(const bf16*)(ws + WS_ACT), (const bf16*)(ws + (ff ? WS_WD1 : WS_WD0)), MTOK, DM, DFF}; pg8::StaticOrder S; S.init(MTOK, DM, gdimx(), bidx());
                EpiResidual E{P.out, DM, 0.5f};

#ifndef NO_G_D
pg8::gemm_phase<EpiResidual, pg8::StaticOrder, GEMM_ARGS>((LAS unsigned char*)lds_raw, g, S, E);
#endif

            }
            if (!(layer == DEPTH - 1 && ff == 1)) SYNC();
            if (ff == 0) {
                { TIDS(); unsigned char* ws = WSP(); rms_phase(P.out, nullptr, P.in[I_GAINS] + (size_t)layer * 3 * DM + DM, (bf16*)(ws + WS_H), gw, ngw, lane); }
                SYNC();
                {
                    unsigned char* ws = WSP();
                    const bool even = !(layer & 1);
                    const int N = even ? 3328 : 768;
                    pg8::Gemm g{(const bf16*)(ws + WS_H), (const bf16*)(ws + WS_WIN), MTOK, N, DM}; pg8::StaticOrder S; S.init(MTOK, N, gdimx(), bidx());
                    EpiStore E;
                    if (even) { E.O0 = (bf16*)(ws + WS_PCONV); E.ldc0 = PCONV_LD; E.ntile0 = 6; E.O1 = (bf16*)(ws + WS_PRW); E.ldc1 = PRW_LD; }
                    else { E.O0 = (bf16*)(ws + WS_PODD); E.ldc0 = PODD_LD; E.ntile0 = 1 << 20; E.O1 = (bf16*)(ws + WS_PODD); E.ldc1 = PODD_LD; }

#ifndef NO_G_WIN
pg8::gemm_phase<EpiStore, pg8::StaticOrder, GEMM_ARGS>((LAS unsigned char*)lds_raw, g, S, E);
#endif

                }
                SYNC();
                if (!(layer & 1)) {
#ifndef NO_CONV
                    { unsigned char* ws = WSP(); TIDS(); conv_phase((const bf16*)(ws + WS_PCONV), P.in[I_ECONV] + (size_t)(layer >> 1) * 3 * 512, (bf16*)(ws + WS_H), bidx_ * NTHR + tid, G * NTHR); }
#endif
                    SYNC();
#ifndef NO_PREP
                    for (int rep_ = 0; rep_ < REP_PREP; ++rep_) { TIDS(); prep_phase<true>(P, layer >> 1, lds_raw, tid, wave, lane); }
#if REP_PREP == 2
                    { TIDS(); prep_phase<false>(P, layer >> 1, lds_raw, tid, wave, lane); }
#endif
#if REP_PREP == 3
                    { TIDS(); prep_phase<true>(P, layer >> 1, lds_raw, tid, wave, lane); }
#endif
#endif
                    SYNC();
#ifndef NO_SCAN
                    for (int rep_ = 0; rep_ < REP_SCAN; ++rep_) { TIDS(); scan_phase(P, (float*)lds_raw, tid, wave, lane); }
#endif
                    SYNC();
#ifndef NO_POST
                    for (int rep_ = 0; rep_ < REP_SMALL; ++rep_) { TIDS(); post_phase(P, layer >> 1, lds_raw, gw, ngw, wave, lane); }
#endif
                    SYNC();
                } else {
#ifndef NO_MLAN
                    for (int rep_ = 0; rep_ < REP_SMALL; ++rep_) { TIDS(); mla_norm_phase(P, layer >> 1, gw, ngw, lane); }
#endif
                    SYNC();
#ifndef NO_G_3
                    {   unsigned char* ws = WSP();
                        pg8::Gemm g{(const bf16*)(ws + WS_CQN), (const bf16*)(ws + WS_WQ), MTOK, 1536, QRANK}; pg8::StaticOrder S; S.init(MTOK, 1536, gdimx(), bidx());
                        EpiStore E{(bf16*)(ws + WS_QB), 1536, 1 << 20, (bf16*)(ws + WS_QB), 1536};
                        pg8::gemm_phase<EpiStore, pg8::StaticOrder, GEMM_ARGS>((LAS unsigned char*)lds_raw, g, S, E); }
                    asm volatile("" : "+s"(layer), "+s"(ff));
                    {   unsigned char* ws = WSP();
                        pg8::Gemm g{(const bf16*)(ws + WS_CKVN), (const bf16*)(ws + WS_WK), MTOK, 1024, KVRANK}; pg8::StaticOrder S; S.init(MTOK, 1024, gdimx(), bidx());
                        EpiStore E{(bf16*)(ws + WS_KNOPE), 1024, 1 << 20, (bf16*)(ws + WS_KNOPE), 1024};
                        pg8::gemm_phase<EpiStore, pg8::StaticOrder, GEMM_ARGS>((LAS unsigned char*)lds_raw, g, S, E); }
                    asm volatile("" : "+s"(layer), "+s"(ff));
                    {   unsigned char* ws = WSP();
                        pg8::Gemm g{(const bf16*)(ws + WS_WV), (const bf16*)(ws + WS_CKVN), 1024, MTOK, KVRANK}; pg8::StaticOrder S; S.init(1024, MTOK, gdimx(), bidx());
                        EpiStoreV E; E.O0 = (bf16*)(ws + WS_VT); E.ldc0 = MTOK; E.ntile0 = 1 << 20; E.O1 = E.O0; E.ldc1 = MTOK;
                        pg8::gemm_phase<EpiStoreV, pg8::StaticOrder, false, true>((LAS unsigned char*)lds_raw, g, S, E); }
#endif
                    SYNC();
#ifndef NO_QKP
                    { TIDS(); qk_prep_phase(P, layer >> 1, lds_raw, gw, ngw, wave, lane); }
#endif
                    SYNC();
#ifndef NO_ATTN
                    for (int rep_ = 0; rep_ < REP_ATTN; ++rep_) { TIDS(); attn_phase(P, lds_raw, tid, wave, lane); }
#endif
                    SYNC();
                }
                {
                    unsigned char* ws = WSP();
                    pg8::Gemm g{(const bf16*)(ws + WS_H), (const bf16*)(ws + WS_WOUT), MTOK, DM, DM}; pg8::StaticOrder S; S.init(MTOK, DM, gdimx(), bidx());
                    EpiResidual E{P.out, DM, 1.0f};

#ifndef NO_G_OUT
pg8::gemm_phase<EpiResidual, pg8::StaticOrder, GEMM_ARGS>((LAS unsigned char*)lds_raw, g, S, E);
#endif

                }
                SYNC();
            }
        }
    }
}

extern "C" void kernel_launch(void* const* d_in, const int* in_sizes, int n_in, void* d_out, int out_size, void* d_ws, size_t ws_size, hipStream_t stream) {
    static int grid = 0;
    if (grid == 0) {
        if (n_in != 28 || out_size != MTOK * DM || ws_size < WS_END) { fprintf(stderr, "kernel_launch: unexpected problem (n_in %d, out %d, ws %zu < %zu)\n", n_in, out_size, ws_size, (size_t)WS_END); grid = -1; return; }
        int dev = 0, cus = 0, per_cu = 0;
        hipGetDevice(&dev); hipDeviceGetAttribute(&cus, hipDeviceAttributeMultiprocessorCount, dev);
        hipFuncSetAttribute((const void*)mega_fwd, hipFuncAttributeMaxDynamicSharedMemorySize, LDS_BYTES);
        hipOccupancyMaxActiveBlocksPerMultiprocessor(&per_cu, (const void*)mega_fwd, NTHR, LDS_BYTES);
        if (per_cu < 1) per_cu = 1;
        grid = cus * per_cu;
        (void)hipGetLastError();
    }
    if (grid < 0) return;
    if (hipMemsetAsync((char*)d_ws + WS_CTL, 0, CTL_BYTES, stream) != hipSuccess) { fprintf(stderr, "memset failed\n"); return; }
    Params p{};
    for (int i = 0; i < 28; ++i) p.in[i] = (const float*)d_in[i];
    p.out = (float*)d_out; p.ws = (unsigned char*)d_ws;
    void* args[] = {&p};
    hipError_t e = hipLaunchCooperativeKernel((const void*)mega_fwd, dim3(grid), dim3(NTHR), args, LDS_BYTES, stream);
    if (e != hipSuccess) fprintf(stderr, "cooperative launch failed: %s (grid %d)\n", hipGetErrorString(e), grid);
}
```

```cpp
#include <hip/hip_runtime.h>
#include <hip/hip_cooperative_groups.h>
#include <cstdio>
#include <cstdint>
namespace cg = cooperative_groups;
namespace pg8 {
#define PG8_LAS __attribute__((address_space(3)))
typedef unsigned short bf16_t;
typedef short bf16x8 __attribute__((ext_vector_type(8)));
typedef float f32x4 __attribute__((ext_vector_type(4)));
typedef unsigned u32x4 __attribute__((ext_vector_type(4)));
constexpr int BM = 256, BK = 64, HALF = 128, HTB = HALF * BK * 2  , STAGE_BYTES = 8 * HTB, NXCD = 8, WGM = 8;

__host__ __device__ __forceinline__ int lds_byte(int r, int c) { const int st = (r >> 4) * 2 + (c >> 5), rr = r & 15, cc = c & 31, ob = rr * 64 + cc * 2; return st * 1024 + (ob ^ (((ob >> 9) & 1) << 5)); }
__host__ __device__ __forceinline__ void stage_rc(int b, int& R, int& C) { const int st = b / 1024, sb = b % 1024, swz = sb ^ (((sb >> 9) & 1) << 5); R = (st >> 1) * 16 + swz / 64; C = (st & 1) * 32 + (swz % 64) / 2; }
__host__ __device__ __forceinline__ int perm32(int rho) { const int n = rho >> 4, i = rho & 15; return 8 * (i >> 2) + 4 * n + (i & 3); }

struct Unit { int pm, pn; };
struct Gemm { const bf16_t* A; const bf16_t* Bt; int M, N, K; };

struct StaticOrder {
    int nM, nN, nwg, G, c;
    __host__ __device__ void init(int M, int N, int G_, int c_) { nM = M / BM; nN = N / BM; nwg = nM * nN; G = G_; c = c_; }
    __host__ __device__ bool next(int i, Unit& u) const {
        const long L = (long)i * G + c; if (L >= nwg) return false;
        int wgid = (int)L; { const int q = nwg / NXCD, r = nwg % NXCD, xcd = wgid % NXCD, off = wgid / NXCD; wgid = (xcd < r ? xcd * (q + 1) : r * (q + 1) + (xcd - r) * q) + off; }
        const int nig = WGM * nN, gid = wgid / nig, fm = gid * WGM, gsz = (nM - fm) < WGM ? (nM - fm) : WGM;
        u.pm = fm + ((wgid % nig) % gsz); u.pn = (wgid % nig) / gsz; return true;
    }
    __device__ __forceinline__ void a_ready(const Unit&) const {}
    __device__ __forceinline__ void done(const Unit&) const {}
};

__device__ __forceinline__ unsigned cvt_pk_bf16(float lo, float hi) { unsigned r; asm volatile("v_cvt_pk_bf16_f32 %0, %1, %2" : "=v"(r) : "v"(lo), "v"(hi)); return r; }
typedef float f32x2 __attribute__((ext_vector_type(2)));
template <class Epi, class Sched, bool ALIGN_EPI = false, bool SP2 = false>
__device__ __forceinline__ void gemm_phase(PG8_LAS unsigned char* lds, const Gemm g, const Sched& S, const Epi& E) {
    int tid_ = threadIdx.x; asm volatile("" : "+v"(tid_));
    const int tid = tid_, wid = __builtin_amdgcn_readfirstlane(tid >> 6), lane = tid & 63, wr = wid >> 2, wc = wid & 3, fr = lane & 15, fq = lane >> 4;
    const int K = g.K, nt = K / BK;
    unsigned voffA[2], voffB[2];
#pragma unroll
    for (int i = 0; i < 2; ++i) { int R, C; stage_rc(tid * 16 + i * 8192, R, C); const int Rb0 = Epi::PERM ? ((R & ~31) + perm32(R & 31)) : R; const int Rb = Epi::VTOK ? ((Rb0 & ~31) + 16 * ((Rb0 >> 2) & 1) + 4 * ((Rb0 >> 3) & 3) + (Rb0 & 3)) : Rb0;
        voffA[i] = (unsigned)(R * K + C) * 2u; voffB[i] = (unsigned)(Rb * K + C) * 2u; }
    const size_t kstep = (size_t)(BK * 2);
    const size_t hstep = (size_t)HALF * K * 2;
    const size_t tstep = 2 * hstep;
    const unsigned ldsw = (unsigned)wid * 1024u;
    const int aoff = lds_byte(wr * 64 + fr, fq * 8), boff = lds_byte(wc * 32 + fr, fq * 8);
#define PG8_SA(b, h) (((b) * 2 + (h)) * HTB)
#define PG8_SB(b, h) ((4 + (b) * 2 + (h)) * HTB)
#define PG8_STAGE(bufoff, gbase, voff) do { _Pragma("unroll") for (int _i = 0; _i < 2; ++_i) \
        __builtin_amdgcn_global_load_lds((const unsigned*)((const char*)(gbase) + (voff)[_i]), (PG8_LAS unsigned*)(lds + (bufoff) + ldsw + _i * 8192), 16, 0, 0); } while (0)
#define PG8_LDA(dst, b, h) do { _Pragma("unroll") for (int m = 0; m < 4; ++m) _Pragma("unroll") for (int k = 0; k < 2; ++k) dst[m][k] = *(const PG8_LAS bf16x8*)(lds + PG8_SA(b, h) + aoff + m * 2048 + k * 1024); } while (0)
#define PG8_LDB(dst, b, h) do { _Pragma("unroll") for (int n = 0; n < 2; ++n) _Pragma("unroll") for (int k = 0; k < 2; ++k) dst[n][k] = *(const PG8_LAS bf16x8*)(lds + PG8_SB(b, h) + boff + n * 2048 + k * 1024); } while (0)
#define PG8_MMA(ai, bj, At, Bt) do { __builtin_amdgcn_s_setprio(1); _Pragma("unroll") for (int m = 0; m < 4; ++m) _Pragma("unroll") for (int n = 0; n < 2; ++n) _Pragma("unroll") for (int k = 0; k < 2; ++k) \
        acc[ai][bj][m][n] = __builtin_amdgcn_mfma_f32_16x16x32_bf16(Bt[n][k], At[m][k], acc[ai][bj][m][n], 0, 0, 0); __builtin_amdgcn_s_setprio(0); } while (0)
#define PG8_WAIT_V(n) asm volatile("s_waitcnt vmcnt(" #n ")" ::: "memory")
#define PG8_WAIT_L(n) asm volatile("s_waitcnt lgkmcnt(" #n ")" ::: "memory")
#define PG8_BAR __builtin_amdgcn_s_barrier()
#define PG8_SCHED __builtin_amdgcn_sched_barrier(0)
    Unit cur, nxt; int ui = 0;
    if (!S.next(0, cur)) return;
    f32x4 acc[2][2][4][2];
#pragma unroll
    for (int a = 0; a < 2; ++a)
#pragma unroll
        for (int b = 0; b < 2; ++b)
#pragma unroll
            for (int m = 0; m < 4; ++m)
#pragma unroll
                for (int n = 0; n < 2; ++n) acc[a][b][m][n] = (f32x4){0.f, 0.f, 0.f, 0.f};
    bf16x8 At[4][2], B0[2][2], B1[2][2];
    const char* cA = (const char*)g.A + (size_t)cur.pm * tstep; const char* cB = (const char*)g.Bt + (size_t)cur.pn * tstep;
    S.a_ready(cur);
    if constexpr (SP2) {
        PG8_STAGE(PG8_SB(0, 0), cB, voffB); PG8_STAGE(PG8_SB(0, 1), cB + hstep, voffB); PG8_STAGE(PG8_SA(0, 0), cA, voffA); PG8_STAGE(PG8_SA(0, 1), cA + hstep, voffA);
        if (wr == 1) PG8_BAR;
        PG8_WAIT_V(2); PG8_BAR;
        PG8_STAGE(PG8_SB(1, 0), cB + kstep, voffB); PG8_STAGE(PG8_SA(1, 0), cA + kstep, voffA); PG8_STAGE(PG8_SB(1, 1), cB + hstep + kstep, voffB);
        PG8_WAIT_V(6); PG8_BAR;
    } else {
        PG8_STAGE(PG8_SB(0, 0), cB, voffB); PG8_STAGE(PG8_SA(0, 0), cA, voffA); PG8_STAGE(PG8_SB(0, 1), cB + hstep, voffB); PG8_STAGE(PG8_SA(0, 1), cA + hstep, voffA);
        if (wr == 1) PG8_BAR;
        PG8_WAIT_V(4); PG8_BAR;
        PG8_STAGE(PG8_SB(1, 0), cB + kstep, voffB); PG8_STAGE(PG8_SA(1, 0), cA + kstep, voffA); PG8_STAGE(PG8_SB(1, 1), cB + hstep + kstep, voffB);
        PG8_WAIT_V(6); PG8_BAR;
    }
    for (;;) {
        const bool has_next = S.next(ui + 1, nxt);
        const char* nA = has_next ? (const char*)g.A + (size_t)nxt.pm * tstep : cA; const char* nB = has_next ? (const char*)g.Bt + (size_t)nxt.pn * tstep : cB;
        for (int t = 0; t < nt; t += 2) {
            const bool last = (t == nt - 2);
            const char* a1 = cA + (size_t)(t + 1) * kstep;
            const char* a2 = last ? nA : cA + (size_t)(t + 2) * kstep; const char* b2 = last ? nB : cB + (size_t)(t + 2) * kstep;
            const char* a3 = a2 + kstep; const char* b3 = b2 + kstep;
            if (last && has_next) S.a_ready(nxt);
            if constexpr (SP2) {
            PG8_LDB(B0, 0, 0); PG8_LDB(B1, 0, 1); PG8_SCHED; PG8_LDA(At, 0, 0); PG8_STAGE(PG8_SA(1, 1), a1 + hstep, voffA);
            PG8_WAIT_V(8); PG8_WAIT_L(0); PG8_BAR; PG8_MMA(0, 0, At, B0); PG8_MMA(0, 1, At, B1); PG8_BAR; PG8_SCHED;
            PG8_LDA(At, 0, 1); PG8_STAGE(PG8_SB(0, 0), b2, voffB); PG8_STAGE(PG8_SB(0, 1), b2 + hstep, voffB); PG8_STAGE(PG8_SA(0, 0), a2, voffA);
            PG8_WAIT_V(8); PG8_WAIT_L(0); PG8_BAR; PG8_MMA(1, 0, At, B0); PG8_MMA(1, 1, At, B1); PG8_BAR; PG8_SCHED;
            PG8_LDB(B0, 1, 0); PG8_LDB(B1, 1, 1); PG8_SCHED; PG8_LDA(At, 1, 0); PG8_STAGE(PG8_SA(0, 1), a2 + hstep, voffA);
            PG8_WAIT_V(8); PG8_WAIT_L(0); PG8_BAR; PG8_MMA(0, 0, At, B0); PG8_MMA(0, 1, At, B1); PG8_BAR; PG8_SCHED;
            PG8_LDA(At, 1, 1); PG8_STAGE(PG8_SB(1, 0), b3, voffB); PG8_STAGE(PG8_SB(1, 1), b3 + hstep, voffB); PG8_STAGE(PG8_SA(1, 0), a3, voffA);
            PG8_WAIT_V(8); PG8_WAIT_L(0); PG8_BAR; PG8_MMA(1, 0, At, B0); PG8_MMA(1, 1, At, B1); PG8_BAR; PG8_SCHED;
            } else {
            PG8_LDB(B0, 0, 0); PG8_SCHED; PG8_LDA(At, 0, 0); PG8_STAGE(PG8_SA(1, 1), a1 + hstep, voffA);
            PG8_WAIT_L(8); PG8_BAR; PG8_WAIT_L(0); PG8_MMA(0, 0, At, B0); PG8_BAR; PG8_SCHED;
            PG8_LDB(B1, 0, 1); PG8_STAGE(PG8_SB(0, 0), b2, voffB);
            PG8_BAR; PG8_WAIT_L(0); PG8_MMA(0, 1, At, B1); PG8_BAR;
            PG8_LDA(At, 0, 1); PG8_STAGE(PG8_SA(0, 0), a2, voffA);
            PG8_BAR; PG8_WAIT_L(0); PG8_MMA(1, 0, At, B0); PG8_BAR; PG8_SCHED;
            PG8_STAGE(PG8_SB(0, 1), b2 + hstep, voffB);
            PG8_WAIT_V(6); PG8_BAR; PG8_MMA(1, 1, At, B1); PG8_BAR;
            PG8_LDB(B0, 1, 0); PG8_SCHED; PG8_LDA(At, 1, 0); PG8_STAGE(PG8_SA(0, 1), a2 + hstep, voffA);
            PG8_WAIT_L(8); PG8_BAR; PG8_WAIT_L(0); PG8_MMA(0, 0, At, B0); PG8_BAR; PG8_SCHED;
            PG8_LDB(B1, 1, 1); PG8_STAGE(PG8_SB(1, 0), b3, voffB);
            PG8_BAR; PG8_WAIT_L(0); PG8_MMA(0, 1, At, B1); PG8_BAR;
            PG8_LDA(At, 1, 1); PG8_STAGE(PG8_SA(1, 0), a3, voffA);
            PG8_BAR; PG8_WAIT_L(0); PG8_MMA(1, 0, At, B0); PG8_BAR; PG8_SCHED;
            PG8_STAGE(PG8_SB(1, 1), b3 + hstep, voffB);
            PG8_WAIT_V(6); PG8_BAR; PG8_MMA(1, 1, At, B1); PG8_BAR;
            }
        }
        if constexpr (ALIGN_EPI) { if (wr == 0) PG8_BAR; }
        if constexpr (!Epi::AFTER_DRAIN) { E(acc, cur, wr, wc, fr, fq); S.done(cur); }
        if (!has_next) break;
#pragma unroll
        for (int a = 0; a < 2; ++a)
#pragma unroll
            for (int b = 0; b < 2; ++b)
#pragma unroll
                for (int m = 0; m < 4; ++m)
#pragma unroll
                    for (int n = 0; n < 2; ++n) acc[a][b][m][n] = (f32x4){0.f, 0.f, 0.f, 0.f};
        cur = nxt; cA = nA; cB = nB; ++ui;
        if constexpr (ALIGN_EPI) { if (wr == 1) PG8_BAR; }
    }
    PG8_WAIT_V(0);
    if constexpr (!ALIGN_EPI) { if (wr == 0) PG8_BAR; }
    PG8_BAR;
    if constexpr (Epi::AFTER_DRAIN) { E.fused(acc, cur, wr, wc, fr, fq, lds, wid, lane); S.done(cur); }
#undef PG8_SA
#undef PG8_SB
#undef PG8_STAGE
#undef PG8_LDA
#undef PG8_LDB
#undef PG8_MMA
#undef PG8_WAIT_V
#undef PG8_WAIT_L
#undef PG8_BAR
#undef PG8_SCHED
}
}

constexpr int DM = 1024, NB = 8, SEQ = 4096, DEPTH = 4, MTOK = NB * SEQ;
constexpr int DFF = 2816;
constexpr int EVEN_IN = 3232, RW_COLS = 1696, PCONV_LD = 1536, PRW_LD = 1792;
constexpr int ODD_IN = 704, PODD_LD = 768, QRANK = 384, KVRANK = 256;
constexpr int NH = 8, QKD = 192, VD = 128;
constexpr float NORM_EPS = 1e-6f, GN_EPS = 64e-5f;
constexpr int NWAVES = 8, NTHR = 512;

typedef unsigned short bf16;
typedef unsigned u32x4 __attribute__((ext_vector_type(4)));
typedef unsigned u32x2 __attribute__((ext_vector_type(2)));
typedef float f32x4 __attribute__((ext_vector_type(4)));
typedef float f32x2 __attribute__((ext_vector_type(2)));
typedef short bf16x8 __attribute__((ext_vector_type(8)));
#define LAS __attribute__((address_space(3)))

constexpr size_t MiB = 1u << 20;
constexpr size_t WS_WGU0 = 0, WS_WD0 = WS_WGU0 + (size_t)2 * DFF * DM * 2, WS_WGU1 = WS_WD0 + (size_t)DM * DFF * 2, WS_WD1 = WS_WGU1 + (size_t)2 * DFF * DM * 2;
constexpr size_t WS_WMIX = 33 * MiB;
static_assert(WS_WD1 + (size_t)DM * DFF * 2 <= WS_WMIX, "ffn weights");
constexpr size_t WS_WIN = WS_WMIX;
constexpr size_t WS_WOUT = WS_WMIX + 7 * MiB;
constexpr size_t WS_WQ = WS_WMIX + 9 * MiB;
constexpr size_t WS_WK = WS_WMIX + 11 * MiB;
constexpr size_t WS_WV = WS_WMIX + 12 * MiB;
constexpr size_t WS_CTL = 47 * MiB, CTL_BYTES = 16384;
constexpr size_t WS_H = 48 * MiB;
constexpr size_t WS_R = 112 * MiB;
constexpr size_t WS_ACT = WS_R;
constexpr size_t WS_PRW = WS_R;
constexpr size_t WS_PCONV = WS_R + 112 * MiB;
constexpr size_t WS_OPS = WS_R + 112 * MiB;
constexpr size_t WS_GBUF = WS_R + 304 * MiB;
constexpr size_t WS_SCAL = WS_R + 336 * MiB;
constexpr size_t WS_YRAW = WS_R;
constexpr size_t WS_PODD = WS_R;
constexpr size_t WS_CQN = WS_R + 48 * MiB;
constexpr size_t WS_CKVN = WS_R + 72 * MiB;
constexpr size_t WS_KF = WS_R;
constexpr size_t WS_QB = WS_R + 96 * MiB;
constexpr size_t WS_KNOPE = WS_R + 192 * MiB;
constexpr size_t WS_VT = WS_R + 256 * MiB;
constexpr size_t WS_KPE = WS_R + 320 * MiB;
constexpr size_t WS_END = WS_R + 340 * MiB;

constexpr int LDS_MISC = 131072 + 320;
constexpr int LDS_BYTES = 147456;

__device__ __forceinline__ float bf2f(bf16 b) { return __uint_as_float((unsigned)b << 16); }
__device__ __forceinline__ float bflo(unsigned w) { return __uint_as_float(w << 16); }
__device__ __forceinline__ float bfhi(unsigned w) { return __uint_as_float(w & 0xffff0000u); }
__device__ __forceinline__ unsigned pk2(float lo, float hi) { return pg8::cvt_pk_bf16(lo, hi); }
__device__ __forceinline__ bf16 f2bf(float f) { return (bf16)(pk2(f, 0.f) & 0xffffu); }
__device__ __forceinline__ float shfl_xor_l(float v, int lane, int mask) { return __int_as_float(__builtin_amdgcn_ds_bpermute((lane ^ mask) << 2, __float_as_int(v))); }
__device__ __forceinline__ void unpack8(const u32x4 w, float (&f)[8]) { f[0] = bflo(w.x); f[1] = bfhi(w.x); f[2] = bflo(w.y); f[3] = bfhi(w.y); f[4] = bflo(w.z); f[5] = bfhi(w.z); f[6] = bflo(w.w); f[7] = bfhi(w.w); }
__device__ __forceinline__ u32x4 pack8(const float (&f)[8]) { u32x4 w; w.x = pk2(f[0], f[1]); w.y = pk2(f[2], f[3]); w.z = pk2(f[4], f[5]); w.w = pk2(f[6], f[7]); return w; }
__device__ __forceinline__ int bidx() { int b = blockIdx.x; asm volatile("" : "+s"(b)); return b; }
__device__ __forceinline__ int gdimx() { int g = gridDim.x; asm volatile("" : "+s"(g)); return g; }
__device__ __forceinline__ float sigmoidf_(float x) { return 1.f / (1.f + __expf(-x)); }
template <int CTRL> __device__ __forceinline__ float dpp_f(float x) { return __int_as_float(__builtin_amdgcn_update_dpp(0, __float_as_int(x), CTRL, 0xF, 0xF, false)); }
__device__ __forceinline__ float row16_sum(float x) {
    x += dpp_f<0x128>(x); x += dpp_f<0x124>(x); x += dpp_f<0x122>(x); x += dpp_f<0x121>(x); return x;
}
__device__ __forceinline__ float wave_sum(float v) {
    v = row16_sum(v);
    const float a = __int_as_float(__builtin_amdgcn_readlane(__float_as_int(v), 0)), b = __int_as_float(__builtin_amdgcn_readlane(__float_as_int(v), 16));
    const float c = __int_as_float(__builtin_amdgcn_readlane(__float_as_int(v), 32)), d = __int_as_float(__builtin_amdgcn_readlane(__float_as_int(v), 48));
    return (a + b) + (c + d);
}

struct EpiStore {
    static constexpr bool PERM = true, AFTER_DRAIN = false, VTOK = false;
    bf16* O0; int ldc0; int ntile0; bf16* O1; int ldc1;
    __device__ __forceinline__ void operator()(const pg8::f32x4 (&acc)[2][2][4][2], const pg8::Unit& u, int wr, int wc, int fr, int fq) const {
        const int row0 = u.pm * 256 + wr * 64 + fr;
        bf16* base; int ldc, colt;
        if (u.pn < ntile0) { base = O0; ldc = ldc0; colt = u.pn * 256; } else { base = O1; ldc = ldc1; colt = (u.pn - ntile0) * 256; }
        const int col0 = colt + wc * 32 + 8 * fq;
#pragma unroll
        for (int ai = 0; ai < 2; ++ai)
#pragma unroll
            for (int m = 0; m < 4; ++m) {
                bf16* rowp = base + (size_t)(row0 + ai * 128 + m * 16) * ldc + col0;
#pragma unroll
                for (int bj = 0; bj < 2; ++bj) {
                    const pg8::f32x4 v0 = acc[ai][bj][m][0], v1 = acc[ai][bj][m][1];
                    u32x4 w; w.x = pk2(v0[0], v0[1]); w.y = pk2(v0[2], v0[3]); w.z = pk2(v1[0], v1[1]); w.w = pk2(v1[2], v1[3]);
                    *(u32x4*)(rowp + bj * 128) = w;
                }
            }
    }
};
struct EpiStoreV : EpiStore { static constexpr bool VTOK = true; };
struct EpiSwiGLU {
    static constexpr bool PERM = true, AFTER_DRAIN = false, VTOK = false;
    bf16* O; int ldc;
    __device__ __forceinline__ void operator()(const pg8::f32x4 (&acc)[2][2][4][2], const pg8::Unit& u, int wr, int wc, int fr, int fq) const {
        const int row0 = u.pm * 256 + wr * 64 + fr;
        const int col0 = u.pn * 128 + wc * 32 + 8 * fq;
#pragma unroll
        for (int ai = 0; ai < 2; ++ai)
#pragma unroll
            for (int m = 0; m < 4; ++m) {
                bf16* rowp = O + (size_t)(row0 + ai * 128 + m * 16) * ldc + col0;
                float r[8];
#pragma unroll
                for (int n = 0; n < 2; ++n)
#pragma unroll
                    for (int j = 0; j < 4; ++j) {
                        const float g = acc[ai][0][m][n][j], up = acc[ai][1][m][n][j];
                        const float s = g * __builtin_amdgcn_rcpf(1.f + __builtin_amdgcn_exp2f(-1.4426950408889634f * g));
                        r[n * 4 + j] = s * up;
                    }
                u32x4 w; w.x = pk2(r[0], r[1]); w.y = pk2(r[2], r[3]); w.z = pk2(r[4], r[5]); w.w = pk2(r[6], r[7]);
                *(u32x4*)rowp = w;
            }
    }
};
struct EpiResidual {
    static constexpr bool PERM = false, AFTER_DRAIN = false, VTOK = false;
    float* X; int ldc; float scale;
    __device__ __forceinline__ void operator()(const pg8::f32x4 (&acc)[2][2][4][2], const pg8::Unit& u, int wr, int wc, int fr, int fq) const {
        const int row0 = u.pm * 256 + wr * 64 + fr;
        const int col0 = u.pn * 256 + wc * 32 + 4 * fq;
#pragma unroll
        for (int ai = 0; ai < 2; ++ai)
#pragma unroll
            for (int m = 0; m < 4; ++m) {
                float* rowp = X + (size_t)(row0 + ai * 128 + m * 16) * ldc + col0;
#pragma unroll
                for (int bj = 0; bj < 2; ++bj)
#pragma unroll
                    for (int n = 0; n < 2; ++n) {
                        f32x4* p = (f32x4*)(rowp + bj * 128 + n * 16);
                        f32x4 v = *p; const pg8::f32x4 a = acc[ai][bj][m][n];
                        v[0] += scale * a[0]; v[1] += scale * a[1]; v[2] += scale * a[2]; v[3] += scale * a[3];
                        *p = v;
                    }
            }
    }
};

__device__ __forceinline__ void tr_item(const float* W, int ldw, int col0, int k0, bf16* WT, int K, int drow0, float* scr, int lane) {
#pragma unroll 8
    for (int i = 0; i < 32; ++i) { const int kk = 2 * i + (lane >> 5); scr[kk * 33 + (lane & 31)] = W[(size_t)(k0 + kk) * ldw + col0 + (lane & 31)]; }
    asm volatile("s_waitcnt lgkmcnt(0)" ::: "memory");
    const int c = lane & 7;
#pragma unroll
    for (int j = 0; j < 4; ++j) {
        const int n = (lane >> 3) + 8 * j; const float* s = scr + (8 * c) * 33 + n;
        u32x4 o; o.x = pk2(s[0 * 33], s[1 * 33]); o.y = pk2(s[2 * 33], s[3 * 33]); o.z = pk2(s[4 * 33], s[5 * 33]); o.w = pk2(s[6 * 33], s[7 * 33]);
        *(u32x4*)(WT + (size_t)(drow0 + n) * K + k0 + 8 * c) = o;
    }
    asm volatile("s_waitcnt lgkmcnt(0)" ::: "memory");
}

struct Params { const float* in[28]; float* out; unsigned char* ws; };
enum { I_X = 0, I_POS, I_GAINS, I_FG, I_FU, I_FD, I_EWIN, I_ECONV, I_EMU, I_W0, I_WUP, I_A0, I_AUP, I_GUP, I_KK, I_KA, I_RK, I_LNW, I_LNB, I_EWOUT,
       I_OWIN, I_QAN, I_KVAN, I_WQUP, I_WKVUP, I_QN, I_KN, I_OWOUT };

__device__ __forceinline__ void convert_layer_weights(const Params& P, int layer, float* scr, int gw, int ngw, int lane) {
    unsigned char* ws = P.ws;
    const int idx = layer >> 1; const bool even = !(layer & 1);
    constexpr int N_GU = (2 * DFF / 32) * (DM / 64);
    constexpr int N_D = (DM / 32) * (DFF / 64);
    constexpr int N_EWIN = (EVEN_IN / 32) * (DM / 64);
    constexpr int N_SQ = (DM / 32) * (DM / 64);
    constexpr int N_OWIN = (ODD_IN / 32) * (DM / 64);
    constexpr int N_WQ = (1536 / 32) * (QRANK / 64);
    constexpr int N_WKV = (1024 / 32) * (KVRANK / 64);
    const int nmix = even ? (N_EWIN + N_SQ) : (N_OWIN + N_WQ + 2 * N_WKV + N_SQ);
    const int total = 2 * (N_GU + N_D) + nmix;
    for (int it = gw; it < total; it += ngw) {
        int r = it;
        if (r < 2 * (N_GU + N_D)) {
            const int ff = r / (N_GU + N_D); r -= ff * (N_GU + N_D);
            const size_t woff = (size_t)(layer * 2 + ff) * DM * DFF;
            if (r < N_GU) {
                const int nb = r % 176, kb = r / 176, nd = 32 * nb, pn = nd >> 8, within = nd & 255, sel = within >> 7;
                const float* src = (sel ? P.in[I_FU] : P.in[I_FG]) + woff;
                tr_item(src, DFF, 128 * pn + (within & 127), 64 * kb, (bf16*)(ws + (ff ? WS_WGU1 : WS_WGU0)), DM, nd, scr, lane);
            } else {
                r -= N_GU; const int nb = r % 32, kb = r / 32;
                tr_item(P.in[I_FD] + woff, DM, 32 * nb, 64 * kb, (bf16*)(ws + (ff ? WS_WD1 : WS_WD0)), DFF, 32 * nb, scr, lane);
            }
            continue;
        }
        r -= 2 * (N_GU + N_D);
        if (even) {
            if (r < N_EWIN) { const int nb = r % 101, kb = r / 101; tr_item(P.in[I_EWIN] + (size_t)idx * DM * EVEN_IN, EVEN_IN, 32 * nb, 64 * kb, (bf16*)(ws + WS_WIN), DM, 32 * nb, scr, lane); continue; }
            r -= N_EWIN;
            { const int nb = r % 32, kb = r / 32; tr_item(P.in[I_EWOUT] + (size_t)idx * DM * DM, DM, 32 * nb, 64 * kb, (bf16*)(ws + WS_WOUT), DM, 32 * nb, scr, lane); }
        } else {
            if (r < N_OWIN) { const int nb = r % 22, kb = r / 22; tr_item(P.in[I_OWIN] + (size_t)idx * DM * ODD_IN, ODD_IN, 32 * nb, 64 * kb, (bf16*)(ws + WS_WIN), DM, 32 * nb, scr, lane); continue; }
            r -= N_OWIN;
            if (r < N_WQ) { const int nb = r % 48, kb = r / 48; tr_item(P.in[I_WQUP] + (size_t)idx * QRANK * 1536, 1536, 32 * nb, 64 * kb, (bf16*)(ws + WS_WQ), QRANK, 32 * nb, scr, lane); continue; }
            r -= N_WQ;
            if (r < 2 * N_WKV) {
                const int sel = r / N_WKV; r -= sel * N_WKV;
                const int nb = r % 32, kb = r / 32, nd = 32 * nb;
                tr_item(P.in[I_WKVUP] + (size_t)idx * KVRANK * 2048, 2048, (nd >> 7) * 256 + sel * 128 + (nd & 127), 64 * kb, (bf16*)(ws + (sel ? WS_WV : WS_WK)), KVRANK, nd, scr, lane);
                continue;
            }
            r -= 2 * N_WKV;
            { const int nb = r % 32, kb = r / 32; tr_item(P.in[I_OWOUT] + (size_t)idx * DM * DM, DM, 32 * nb, 64 * kb, (bf16*)(ws + WS_WOUT), DM, 32 * nb, scr, lane); }
        }
    }
}

__device__ __forceinline__ void rms_phase(const float* src, float* cpy, const float* gain, bf16* dst, int gw, int ngw, int lane) {
    f32x4 g[4];
#pragma unroll
    for (int j = 0; j < 4; ++j) g[j] = ((const f32x4*)gain)[lane + 64 * j];
    for (int m = 2 * gw; m < MTOK; m += 2 * ngw) {
        f32x4 v[2][4]; float s[2] = {0.f, 0.f};
#pragma unroll
        for (int u = 0; u < 2; ++u) { const f32x4* xr = (const f32x4*)(src + (size_t)(m + u) * DM) + lane;
#pragma unroll
            for (int j = 0; j < 4; ++j) v[u][j] = xr[64 * j]; }
#pragma unroll
        for (int u = 0; u < 2; ++u) {
#pragma unroll
            for (int j = 0; j < 4; ++j) s[u] += (v[u][j].x * v[u][j].x + v[u][j].y * v[u][j].y) + (v[u][j].z * v[u][j].z + v[u][j].w * v[u][j].w);
            if (cpy) { f32x4* cr = (f32x4*)(cpy + (size_t)(m + u) * DM) + lane;
#pragma unroll
                for (int j = 0; j < 4; ++j) cr[64 * j] = v[u][j]; }
        }
#pragma unroll
        for (int u = 0; u < 2; ++u) {
            const float rstd = rsqrtf(wave_sum(s[u]) * (1.f / DM) + NORM_EPS);
            u32x2* o8 = (u32x2*)(dst + (size_t)(m + u) * DM) + lane;
#pragma unroll
            for (int j = 0; j < 4; ++j) { u32x2 o; o.x = pk2(v[u][j].x * rstd * g[j].x, v[u][j].y * rstd * g[j].y); o.y = pk2(v[u][j].z * rstd * g[j].z, v[u][j].w * rstd * g[j].w); o8[64 * j] = o; }
        }
    }
}

__device__ __forceinline__ void conv_phase(const bf16* pconv, const float* cw, bf16* ycat, int gtid, int nthr) {
#pragma unroll 2
    for (int item = gtid; item < MTOK * 64; item += nthr) {
        const int m = item >> 6, c8 = (item & 63) * 8, t = m & (SEQ - 1);
        const bf16* row = pconv + (size_t)m * PCONV_LD;
        const u32x4 gb = *(const u32x4*)(row + c8), gc0 = *(const u32x4*)(row + 512 + c8), hi0 = *(const u32x4*)(row + 1024 + c8);
        const bf16* row1 = t >= 1 ? row - PCONV_LD : row; const bf16* row2 = t >= 2 ? row - 2 * PCONV_LD : row;
        u32x4 gc1 = *(const u32x4*)(row1 + 512 + c8), hi1 = *(const u32x4*)(row1 + 1024 + c8), gc2 = *(const u32x4*)(row2 + 512 + c8), hi2 = *(const u32x4*)(row2 + 1024 + c8);
        const unsigned k1 = t >= 1 ? 0xffffffffu : 0u, k2 = t >= 2 ? 0xffffffffu : 0u;
        gc1.x &= k1; gc1.y &= k1; gc1.z &= k1; gc1.w &= k1; gc2.x &= k2; gc2.y &= k2; gc2.z &= k2; gc2.w &= k2;
        float y[8];
#pragma unroll
        for (int e = 0; e < 4; ++e) {
            const float w0a = cw[c8 + 2 * e], w0b = cw[c8 + 2 * e + 1], w1a = cw[512 + c8 + 2 * e], w1b = cw[512 + c8 + 2 * e + 1], w2a = cw[1024 + c8 + 2 * e], w2b = cw[1024 + c8 + 2 * e + 1];
            const float u0a = bflo(gc0[e]) * bflo(hi0[e]), u0b = bfhi(gc0[e]) * bfhi(hi0[e]);
            const float u1a = bflo(gc1[e]) * bflo(hi1[e]), u1b = bfhi(gc1[e]) * bfhi(hi1[e]);
            const float u2a = bflo(gc2[e]) * bflo(hi2[e]), u2b = bfhi(gc2[e]) * bfhi(hi2[e]);
            y[2 * e] = bflo(gb[e]) * (w0a * u2a + w1a * u1a + w2a * u0a);
            y[2 * e + 1] = bfhi(gb[e]) * (w0b * u2b + w1b * u1b + w2b * u0b);
        }
        u32x4 o; o.x = pk2(y[0], y[1]); o.y = pk2(y[2], y[3]); o.z = pk2(y[4], y[5]); o.w = pk2(y[6], y[7]);
        *(u32x4*)(ycat + (size_t)m * DM + c8) = o;
    }
}

constexpr int PP_LIN_LD = 168;
constexpr int PP_CST = 8192, PP_GFR = 32768;
__device__ __forceinline__ float fast_sigmoid(float x) { return __builtin_amdgcn_rcpf(1.f + __expf(-x)); }
template <bool STORE> __device__ __forceinline__ void prep_phase(const Params& P, int idx, unsigned char* lds, int tid, int wave, int lane) {
    const int BIDX = bidx(), GDIMX = gdimx();
    const bf16* prw = (const bf16*)(P.ws + WS_PRW);
    bf16* ops = (bf16*)(P.ws + WS_OPS); bf16* gbuf = (bf16*)(P.ws + WS_GBUF); float* scal = (float*)(P.ws + WS_SCAL);
    const float* mu = P.in[I_EMU] + (size_t)idx * RW_COLS;
    const int fr = lane & 15, g = lane >> 4, h = wave;
    bf16* lin = (bf16*)lds; float* cst = (float*)(lds + PP_CST);
    cst[0 * 512 + tid] = P.in[I_W0][idx * 512 + tid]; cst[1 * 512 + tid] = P.in[I_A0][idx * 512 + tid]; cst[2 * 512 + tid] = P.in[I_KK][idx * 512 + tid]; cst[3 * 512 + tid] = P.in[I_KA][idx * 512 + tid];
    cst[4 * 512 + tid] = P.in[I_RK][idx * 512 + tid]; cst[5 * 512 + tid] = mu[tid]; cst[6 * 512 + tid] = mu[512 + tid]; cst[7 * 512 + tid] = mu[1024 + tid];
    bf16x8 wfr[4], afr[4];
    const float* wup = P.in[I_WUP] + (size_t)idx * 32 * 512; const float* aup = P.in[I_AUP] + (size_t)idx * 32 * 512; const float* gup = P.in[I_GUP] + (size_t)idx * 96 * 512;
#pragma unroll
    for (int nb = 0; nb < 4; ++nb) {
        const int col = 64 * h + 16 * nb + fr;
        u32x4 ww, aa;
        ww.x = pk2(wup[(8 * g + 0) * 512 + col], wup[(8 * g + 1) * 512 + col]); ww.y = pk2(wup[(8 * g + 2) * 512 + col], wup[(8 * g + 3) * 512 + col]);
        ww.z = pk2(wup[(8 * g + 4) * 512 + col], wup[(8 * g + 5) * 512 + col]); ww.w = pk2(wup[(8 * g + 6) * 512 + col], wup[(8 * g + 7) * 512 + col]);
        aa.x = pk2(aup[(8 * g + 0) * 512 + col], aup[(8 * g + 1) * 512 + col]); aa.y = pk2(aup[(8 * g + 2) * 512 + col], aup[(8 * g + 3) * 512 + col]);
        aa.z = pk2(aup[(8 * g + 4) * 512 + col], aup[(8 * g + 5) * 512 + col]); aa.w = pk2(aup[(8 * g + 6) * 512 + col], aup[(8 * g + 7) * 512 + col]);
        wfr[nb] = __builtin_bit_cast(bf16x8, ww); afr[nb] = __builtin_bit_cast(bf16x8, aa);
#pragma unroll
        for (int ks = 0; ks < 3; ++ks) {
            const int kb = 32 * ks + 8 * g; u32x4 gg_;
            gg_.x = pk2(gup[(kb + 0) * 512 + col], gup[(kb + 1) * 512 + col]); gg_.y = pk2(gup[(kb + 2) * 512 + col], gup[(kb + 3) * 512 + col]);
            gg_.z = pk2(gup[(kb + 4) * 512 + col], gup[(kb + 5) * 512 + col]); gg_.w = pk2(gup[(kb + 6) * 512 + col], gup[(kb + 7) * 512 + col]);
            *(u32x4*)(lds + PP_GFR + ((((h * 3 + ks) * 4 + nb) * 64 + lane) * 16)) = gg_;
        }
    }
    __syncthreads();
    for (int tile = BIDX; tile < MTOK / 16; tile += GDIMX) {
        const int m0 = tile * 16;
        if (tid < 320) {
            const int tok = tid / 20, ch = tid - tok * 20, m = m0 + tok, t = m & (SEQ - 1);
            const u32x4 wc = *(const u32x4*)(prw + (size_t)m * PRW_LD + 1536 + 8 * ch);
            const u32x4 wp = *(const u32x4*)(prw + (size_t)(t ? m - 1 : m) * PRW_LD + 1536 + 8 * ch);
            const f32x4 mu0 = *(const f32x4*)(mu + 1536 + 8 * ch), mu1 = *(const f32x4*)(mu + 1536 + 8 * ch + 4);
            float cur[8], prv[8], f[8]; unpack8(wc, cur); unpack8(wp, prv);
            const float mus[8] = {mu0.x, mu0.y, mu0.z, mu0.w, mu1.x, mu1.y, mu1.z, mu1.w};
#pragma unroll
            for (int e = 0; e < 8; ++e) {
                const float pv = t ? prv[e] : 0.f;
                const float x = cur[e] + (pv - cur[e]) * mus[e];
                const float th = 1.f - 2.f * __builtin_amdgcn_rcpf(1.f + __expf(2.f * x)), sg = fast_sigmoid(x);
                f[e] = ch < 4 ? th : (ch < 8 ? x : sg);
            }
            *(u32x4*)(lin + tok * PP_LIN_LD + 8 * ch) = pack8(f);
        }
        __syncthreads();
        const int m = m0 + fr, t = m & (SEQ - 1), b = m >> 12;
        const bf16* row = prw + (size_t)m * PRW_LD + 64 * h + 4 * g;
        u32x2 rc[4], kc[4], vc[4], rp[4], kp[4], vp[4];
#pragma unroll
        for (int nb = 0; nb < 4; ++nb) { rc[nb] = *(const u32x2*)(row + 16 * nb); kc[nb] = *(const u32x2*)(row + 512 + 16 * nb); vc[nb] = *(const u32x2*)(row + 1024 + 16 * nb); }
        {   const bf16* prow = t ? row - PRW_LD : row; const unsigned keep = t ? 0xffffffffu : 0u;
#pragma unroll
            for (int nb = 0; nb < 4; ++nb) { rp[nb] = *(const u32x2*)(prow + 16 * nb); kp[nb] = *(const u32x2*)(prow + 512 + 16 * nb); vp[nb] = *(const u32x2*)(prow + 1024 + 16 * nb);
                rp[nb].x &= keep; rp[nb].y &= keep; kp[nb].x &= keep; kp[nb].y &= keep; vp[nb].x &= keep; vp[nb].y &= keep; }
        }
        bf16x8 bfr[5];
#pragma unroll
        for (int ks = 0; ks < 5; ++ks) bfr[ks] = *(const bf16x8*)(lin + fr * PP_LIN_LD + 32 * ks + 8 * g);
        float ss = 0.f;
#pragma unroll
        for (int nb = 0; nb < 4; ++nb) {
            const int cb = 64 * h + 16 * nb + 4 * g;
            const f32x4 muk = *(const f32x4*)(cst + 6 * 512 + cb), kkc = *(const f32x4*)(cst + 2 * 512 + cb);
            const float c0 = bflo(kc[nb].x), c1 = bfhi(kc[nb].x), c2 = bflo(kc[nb].y), c3 = bfhi(kc[nb].y);
            const float p0 = bflo(kp[nb].x), p1 = bfhi(kp[nb].x), p2 = bflo(kp[nb].y), p3 = bfhi(kp[nb].y);
            const float q0 = (c0 + (p0 - c0) * muk.x) * kkc.x, q1 = (c1 + (p1 - c1) * muk.y) * kkc.y, q2 = (c2 + (p2 - c2) * muk.z) * kkc.z, q3 = (c3 + (p3 - c3) * muk.w) * kkc.w;
            ss += (q0 * q0 + q1 * q1) + (q2 * q2 + q3 * q3);
        }
        ss += shfl_xor_l(ss, lane, 16); ss += shfl_xor_l(ss, lane, 32);
        const float kinv = rsqrtf(fmaxf(ss, 1e-24f));
        float br = 0.f, kr = 0.f, rk = 0.f;
        bf16* op = ops + ((size_t)(b * NH + h) * (SEQ / 16) + (t >> 4)) * 6144 + lane * 4;
        bf16* gp = gbuf + ((size_t)tile * NH + h) * 1024 + lane * 4;
#pragma unroll
        for (int nb = 0; nb < 4; ++nb) {
            const int cb = 64 * h + 16 * nb + 4 * g;
            const f32x4 w0c = *(const f32x4*)(cst + 0 * 512 + cb), a0c = *(const f32x4*)(cst + 1 * 512 + cb), kkc = *(const f32x4*)(cst + 2 * 512 + cb), kac = *(const f32x4*)(cst + 3 * 512 + cb);
            const f32x4 rkc = *(const f32x4*)(cst + 4 * 512 + cb), mur = *(const f32x4*)(cst + 5 * 512 + cb), muv = *(const f32x4*)(cst + 7 * 512 + cb);
            const f32x4 muk = *(const f32x4*)(cst + 6 * 512 + cb);
            const pg8::f32x4 z0 = {0.f, 0.f, 0.f, 0.f};
            const pg8::f32x4 zw = __builtin_amdgcn_mfma_f32_16x16x32_bf16(wfr[nb], bfr[0], z0, 0, 0, 0);
            const pg8::f32x4 za = __builtin_amdgcn_mfma_f32_16x16x32_bf16(afr[nb], bfr[1], z0, 0, 0, 0);
            pg8::f32x4 gg = z0;
#pragma unroll
            for (int ks = 0; ks < 3; ++ks) gg = __builtin_amdgcn_mfma_f32_16x16x32_bf16(*(const bf16x8*)(lds + PP_GFR + ((((h * 3 + ks) * 4 + nb) * 64 + lane) * 16)), bfr[2 + ks], gg, 0, 0, 0);
            float o_um[4], o_wr[4], o_a[4], o_b[4], o_k[4], o_v[4], o_g[4];
#pragma unroll
            for (int r4 = 0; r4 < 4; ++r4) {
                const unsigned rcw = r4 < 2 ? rc[nb].x : rc[nb].y, rpw = r4 < 2 ? rp[nb].x : rp[nb].y, vcw = r4 < 2 ? vc[nb].x : vc[nb].y, vpw = r4 < 2 ? vp[nb].x : vp[nb].y;
                const unsigned kcw = r4 < 2 ? kc[nb].x : kc[nb].y, kpw = r4 < 2 ? kp[nb].x : kp[nb].y;
                const float kcur = (r4 & 1) ? bfhi(kcw) : bflo(kcw), kprev = (r4 & 1) ? bfhi(kpw) : bflo(kpw);
                const float rcur = (r4 & 1) ? bfhi(rcw) : bflo(rcw), rprev = (r4 & 1) ? bfhi(rpw) : bflo(rpw), vcur = (r4 & 1) ? bfhi(vcw) : bflo(vcw), vprev = (r4 & 1) ? bfhi(vpw) : bflo(vpw);
                const float r = rcur + (rprev - rcur) * mur[r4], v = vcur + (vprev - vcur) * muv[r4], k = kcur + (kprev - kcur) * muk[r4];
                const float nz = -(w0c[r4] + zw[r4]);
                const float sp = fmaxf(nz, 0.f) + __logf(1.f + __expf(-fabsf(nz)));
                const float e = __expf(-sp - 0.5f);
                const float wdec = __expf(-e), um = 1.f - wdec;
                const float iclr = fast_sigmoid(a0c[r4] + za[r4]);
                const float kk = k * kkc[r4] * kinv;
                const float kh = k * (1.f + (iclr - 1.f) * kac[r4]);
                const float bv = kk * iclr;
                br += bv * r; kr += kh * r; rk += r * kh * rkc[r4];
                o_um[r4] = um; o_wr[r4] = wdec * r; o_a[r4] = -kk; o_b[r4] = bv; o_k[r4] = kh; o_v[r4] = v; o_g[r4] = gg[r4];
            }
            u32x2 w2; if (STORE) {
            w2.x = pk2(o_um[0], o_um[1]); w2.y = pk2(o_um[2], o_um[3]); *(u32x2*)(op + (0 + nb) * 256) = w2;
            w2.x = pk2(o_wr[0], o_wr[1]); w2.y = pk2(o_wr[2], o_wr[3]); *(u32x2*)(op + (4 + nb) * 256) = w2;
            w2.x = pk2(o_a[0], o_a[1]); w2.y = pk2(o_a[2], o_a[3]); *(u32x2*)(op + (8 + nb) * 256) = w2;
            w2.x = pk2(o_b[0], o_b[1]); w2.y = pk2(o_b[2], o_b[3]); *(u32x2*)(op + (12 + nb) * 256) = w2;
            w2.x = pk2(o_k[0], o_k[1]); w2.y = pk2(o_k[2], o_k[3]); *(u32x2*)(op + (16 + nb) * 256) = w2;
            w2.x = pk2(o_v[0], o_v[1]); w2.y = pk2(o_v[2], o_v[3]); *(u32x2*)(op + (20 + nb) * 256) = w2;
            w2.x = pk2(o_g[0], o_g[1]); w2.y = pk2(o_g[2], o_g[3]); *(u32x2*)(gp + nb * 256) = w2; }
            else { asm volatile("" :: "v"(o_um[0] + o_wr[1] + o_a[2] + o_b[3] + o_k[0] + o_v[1] + o_g[2])); }
        }
        br += shfl_xor_l(br, lane, 16); br += shfl_xor_l(br, lane, 32);
        kr += shfl_xor_l(kr, lane, 16); kr += shfl_xor_l(kr, lane, 32);
        rk += shfl_xor_l(rk, lane, 16); rk += shfl_xor_l(rk, lane, 32);
        if (!STORE) { asm volatile("" :: "v"(br + kr + rk)); } else if (g == 0) { f32x4 s4 = {br, kr, rk, 0.f}; *(f32x4*)(scal + ((size_t)(b * NH + h) * SEQ + t) * 4) = s4; }
        __syncthreads();
    }
}

constexpr int SC_TC = 32, SC_STEP = 340, SC_BUF = SC_TC * SC_STEP;
struct StepOps { f32x4 W, AW0, AW1, B, K; float v; f32x2 sc; };
__device__ __forceinline__ void sc_load(StepOps& o, const float* p, int wq, int row16) {
    o.W = *(const f32x4*)(p + wq); o.AW0 = *(const f32x4*)(p + 64 + wq); o.AW1 = *(const f32x4*)(p + 128 + wq); o.B = *(const f32x4*)(p + 192 + wq); o.K = *(const f32x4*)(p + 256 + wq);
    o.v = p[320 + row16]; o.sc = *(const f32x2*)(p + 336);
}
__device__ __forceinline__ void scan_phase(const Params& P, float* lds, int tid, int wave, int lane) {
    const int BIDX = bidx(), GDIMX = gdimx();
    const bf16* ops = (const bf16*)(P.ws + WS_OPS); const float* scal = (const float*)(P.ws + WS_SCAL); float* yraw = (float*)(P.ws + WS_YRAW);
    float* buf0 = lds; float* ybuf0 = lds + 2 * SC_BUF;
    const int vcu = (GDIMX % 8 == 0) ? (BIDX % 8) * (GDIMX / 8) + BIDX / 8 : BIDX;
    for (int unit = vcu; unit < 256; unit += GDIMX) {
        const int bh = unit >> 2, rq = unit & 3, b = bh >> 3, hh = bh & 7;
        const bool loader = wave >= 4; const int ltid = tid - 256;
        const int ks = lane & 15, row16 = (wave & 3) * 4 + (lane >> 4), wq = 4 * ks;
        float s0 = 0.f, s1 = 0.f, s2 = 0.f, s3 = 0.f;
        const int ydelta = row16 * 8 + (ks & 7);
        u32x4 ld_[6]; f32x4 sc4_ = {0.f, 0.f, 0.f, 0.f};
#define SC_LOAD(c) do { const int t0_ = (c) * SC_TC; const bf16* src_ = ops + ((size_t)bh * (SEQ / 16) + (t0_ >> 4)) * 6144; \
            _Pragma("unroll") for (int i = 0; i < 6; ++i) ld_[i] = *(const u32x4*)(src_ + (size_t)(ltid + 256 * i) * 8); \
            if (ltid < 32) sc4_ = *(const f32x4*)(scal + ((size_t)bh * SEQ + t0_ + ltid) * 4); } while (0)
#define SC_WRITE(c) do { float* bufw = buf0 + ((c) & 1) * SC_BUF; \
            _Pragma("unroll") for (int i = 0; i < 6; ++i) { const int id = ltid + 256 * i, tl = id / 768, rem = id - tl * 768, vec = rem >> 7, r2 = rem & 127, nb = r2 >> 5, lp = r2 & 31; \
                const int tk = tl * 16 + ((2 * lp) & 15), gq = (2 * lp) >> 4;        \
                f32x4 lo_ = {bflo(ld_[i].x), bfhi(ld_[i].x), bflo(ld_[i].y), bfhi(ld_[i].y)}, hi_ = {bflo(ld_[i].z), bfhi(ld_[i].z), bflo(ld_[i].w), bfhi(ld_[i].w)}; \
                if (vec == 0) { lo_ = 1.f - lo_; hi_ = 1.f - hi_; } \
                if (vec == 1 || vec == 2) { float* d_ = bufw + tk * SC_STEP + 64 + 4 * (4 * nb + gq) + (vec == 1 ? 1 : 0);        \
                    d_[0] = lo_.x; d_[2] = lo_.y; d_[64] = lo_.z; d_[66] = lo_.w; d_ += SC_STEP; d_[0] = hi_.x; d_[2] = hi_.y; d_[64] = hi_.z; d_[66] = hi_.w; } \
                else if (vec < 5) { float* d_ = bufw + tk * SC_STEP + vec * 64 + 16 * nb + 4 * gq; *(f32x4*)d_ = lo_; *(f32x4*)(d_ + SC_STEP) = hi_; } \
                else if (nb == rq) { float* d_ = bufw + tk * SC_STEP + 320 + 4 * gq; *(f32x4*)d_ = lo_; *(f32x4*)(d_ + SC_STEP) = hi_; } } \
            if (ltid < 32) { f32x2 s2_ = {sc4_.x * 0.125f, sc4_.y * 0.125f}; *(f32x2*)(bufw + ltid * SC_STEP + 336) = s2_; } } while (0)
#define SC_YOUT(c) do { const float* yb_ = ybuf0 + ((c) & 1) * (SC_TC * 128); const int t0_ = (c) * SC_TC; \
            _Pragma("unroll") for (int i = 0; i < 2; ++i) { const int id = ltid + 256 * i; \
                const f32x4 pa_ = *(const f32x4*)(yb_ + id * 8), pb_ = *(const f32x4*)(yb_ + id * 8 + 4);        \
                yraw[((size_t)(bh * 4 + rq) * SEQ + t0_) * 16 + id] = ((pa_.x + pa_.y) + (pa_.z + pa_.w)) + ((pb_.x + pb_.y) + (pb_.z + pb_.w)); } } while (0)
        constexpr int NCH = SEQ / SC_TC;
        if (loader) { SC_LOAD(0); SC_WRITE(0); SC_LOAD(1); }
        __syncthreads();
        for (int c = 0; c < NCH; ++c) {
            if (loader) {
                if (c + 1 < NCH) SC_WRITE(c + 1);
                if (c + 2 < NCH) SC_LOAD(c + 2);
                if (c > 0) SC_YOUT(c - 1);
            } else {
                __builtin_amdgcn_s_setprio(1);
                const float* bufr = buf0 + (c & 1) * SC_BUF; float* ybl = ybuf0 + (c & 1) * (SC_TC * 128) + ydelta;
                StepOps cur, nxt;
                sc_load(cur, bufr, wq, row16);
#pragma unroll 16
                for (int st = 0; st < SC_TC; ++st) {
                    sc_load(nxt, bufr + (st + 1 < SC_TC ? st + 1 : st) * SC_STEP, wq, row16);
                    f32x2 dd = (f32x2){cur.AW0.x, cur.AW0.y} * s0;
                    dd += (f32x2){cur.AW0.z, cur.AW0.w} * s1; dd += (f32x2){cur.AW1.x, cur.AW1.y} * s2; dd += (f32x2){cur.AW1.z, cur.AW1.w} * s3;
                    float da = dd.x, dy = dd.y;
                    da = row16_sum(da); dy += dpp_f<0x128>(dy);
                    s0 = s0 * cur.W.x + da * cur.B.x + cur.v * cur.K.x;
                    s1 = s1 * cur.W.y + da * cur.B.y + cur.v * cur.K.y;
                    s2 = s2 * cur.W.z + da * cur.B.z + cur.v * cur.K.z;
                    s3 = s3 * cur.W.w + da * cur.B.w + cur.v * cur.K.w;
                    const float y = dy + da * cur.sc.x + cur.v * cur.sc.y;
                    ybl[st * 128] = y;
                    cur = nxt;
                }
                __builtin_amdgcn_s_setprio(0);
            }
            __syncthreads();
        }
        if (loader) SC_YOUT(NCH - 1);
        __syncthreads();
#undef SC_LOAD
#undef SC_WRITE
#undef SC_YOUT
    }
}

__device__ __forceinline__ void post_phase(const Params& P, int idx, unsigned char* lds, int gw, int ngw, int wave, int lane) {
    const float* yraw = (const float*)(P.ws + WS_YRAW); const bf16* ops = (const bf16*)(P.ws + WS_OPS); const float* scal = (const float*)(P.ws + WS_SCAL);
    const bf16* gbuf = (const bf16*)(P.ws + WS_GBUF); bf16* ycat = (bf16*)(P.ws + WS_H);
    const int fr = lane & 15, g = lane >> 4;
    unsigned char* stg = lds + wave * 2304;
    for (int task = gw; task < (MTOK / 16) * NH; task += ngw) {
        const int tile = task >> 3, h = task & 7, m = tile * 16 + fr, t = m & (SEQ - 1), b = m >> 12, bh = b * NH + h;
        f32x4 y[4], lw[4], lb[4]; u32x2 vv[4], gg[4];
#pragma unroll
        for (int nb = 0; nb < 4; ++nb) {
            y[nb] = *(const f32x4*)(yraw + ((size_t)(bh * 4 + nb) * SEQ + t) * 16 + 4 * g);
            vv[nb] = *(const u32x2*)(ops + ((size_t)bh * (SEQ / 16) + (t >> 4)) * 6144 + (20 + nb) * 256 + lane * 4);
            gg[nb] = *(const u32x2*)(gbuf + ((size_t)tile * NH + h) * 1024 + nb * 256 + lane * 4);
            lw[nb] = *(const f32x4*)(P.in[I_LNW] + idx * 512 + h * 64 + 16 * nb + 4 * g);
            lb[nb] = *(const f32x4*)(P.in[I_LNB] + idx * 512 + h * 64 + 16 * nb + 4 * g);
        }
        const float rk = scal[((size_t)bh * SEQ + t) * 4 + 2];
        float sm = 0.f;
#pragma unroll
        for (int nb = 0; nb < 4; ++nb) sm += (y[nb].x + y[nb].y) + (y[nb].z + y[nb].w);
        sm += shfl_xor_l(sm, lane, 16); sm += shfl_xor_l(sm, lane, 32);
        const float mean = sm * (1.f / 64.f);
        float sv = 0.f;
#pragma unroll
        for (int nb = 0; nb < 4; ++nb) { y[nb] = y[nb] - mean; sv += (y[nb].x * y[nb].x + y[nb].y * y[nb].y) + (y[nb].z * y[nb].z + y[nb].w * y[nb].w); }
        sv += shfl_xor_l(sv, lane, 16); sv += shfl_xor_l(sv, lane, 32);
        const float rstd = rsqrtf(sv * (1.f / 64.f) + GN_EPS);
#pragma unroll
        for (int nb = 0; nb < 4; ++nb) {
            const float v0 = bflo(vv[nb].x), v1 = bfhi(vv[nb].x), v2 = bflo(vv[nb].y), v3 = bfhi(vv[nb].y);
            const float g0 = bflo(gg[nb].x), g1 = bfhi(gg[nb].x), g2 = bflo(gg[nb].y), g3 = bfhi(gg[nb].y);
            const float o0 = (y[nb].x * rstd * lw[nb].x + lb[nb].x + rk * v0) * g0, o1 = (y[nb].y * rstd * lw[nb].y + lb[nb].y + rk * v1) * g1;
            const float o2 = (y[nb].z * rstd * lw[nb].z + lb[nb].z + rk * v2) * g2, o3 = (y[nb].w * rstd * lw[nb].w + lb[nb].w + rk * v3) * g3;
            u32x2 w; w.x = pk2(o0, o1); w.y = pk2(o2, o3);
            *(u32x2*)(stg + fr * 144 + (16 * nb + 4 * g) * 2) = w;
        }
        asm volatile("s_waitcnt lgkmcnt(0)" ::: "memory");
#pragma unroll
        for (int i = 0; i < 2; ++i) { const int rowi = 8 * i + (lane >> 3), ch = lane & 7;
            const u32x4 w = *(const u32x4*)(stg + rowi * 144 + ch * 16);
            *(u32x4*)(ycat + (size_t)(tile * 16 + rowi) * DM + 512 + h * 64 + ch * 8) = w; }
        asm volatile("s_waitcnt lgkmcnt(0)" ::: "memory");
    }
}

__device__ __forceinline__ void mla_norm_phase(const Params& P, int idx, int gw, int ngw, int lane) {
    const bf16* podd = (const bf16*)(P.ws + WS_PODD); bf16* cqn = (bf16*)(P.ws + WS_CQN); bf16* ckvn = (bf16*)(P.ws + WS_CKVN); bf16* kpe = (bf16*)(P.ws + WS_KPE);
    float gq[8], gk[8];
    const int lq = lane < 48 ? lane : 0, lk = lane < 32 ? lane : 0, lp = lane < 8 ? lane : 0;
#pragma unroll
    for (int e = 0; e < 8; ++e) { gq[e] = P.in[I_QAN][idx * QRANK + 8 * lq + e]; gk[e] = P.in[I_KVAN][idx * KVRANK + 8 * lk + e]; }
    for (int m0 = 2 * gw; m0 < MTOK; m0 += 2 * ngw) {
        u32x4 wq[2], wk[2], wp[2];
#pragma unroll
        for (int u = 0; u < 2; ++u) { const bf16* row = podd + (size_t)(m0 + u) * PODD_LD;
            wq[u] = *(const u32x4*)(row + 8 * lq); wk[u] = *(const u32x4*)(row + QRANK + 8 * lk); wp[u] = *(const u32x4*)(row + QRANK + KVRANK + 8 * lp); }
#pragma unroll
        for (int u = 0; u < 2; ++u) { const int m = m0 + u;
            float q[8], k[8]; unpack8(wq[u], q); unpack8(wk[u], k);
            float sq = 0.f, sk = 0.f;
#pragma unroll
            for (int e = 0; e < 8; ++e) { sq += q[e] * q[e]; sk += k[e] * k[e]; }
            sq = lane < 48 ? sq : 0.f; sk = lane < 32 ? sk : 0.f;
            const float rq = rsqrtf(wave_sum(sq) * (1.f / QRANK) + NORM_EPS), rk = rsqrtf(wave_sum(sk) * (1.f / KVRANK) + NORM_EPS);
#pragma unroll
            for (int e = 0; e < 8; ++e) { q[e] *= rq * gq[e]; k[e] *= rk * gk[e]; }
            if (lane < 48) *(u32x4*)(cqn + (size_t)m * QRANK + 8 * lane) = pack8(q);
            if (lane < 32) *(u32x4*)(ckvn + (size_t)m * KVRANK + 8 * lane) = pack8(k);
            if (lane < 8) *(u32x4*)(kpe + (size_t)m * 64 + 8 * lane) = wp[u]; }
    }
}

constexpr float ATTN_C2 = 0.07216878364870322f * 1.4426950408889634f;
__device__ __forceinline__ void qk_prep_phase(const Params& P, int idx, unsigned char* lds, int gw, int ngw, int wave, int lane) {
    bf16* qb = (bf16*)(P.ws + WS_QB); const bf16* knope = (const bf16*)(P.ws + WS_KNOPE); const bf16* kpe = (const bf16*)(P.ws + WS_KPE); bf16* kf = (bf16*)(P.ws + WS_KF);
    const int* pos = (const int*)P.in[I_POS];
    const int h = lane >> 3, s = lane & 7;
    float qg[24], kg[24];
#pragma unroll
    for (int e = 0; e < 16; ++e) { qg[e] = P.in[I_QN][idx * QKD + 16 * s + e]; kg[e] = P.in[I_KN][idx * QKD + 16 * s + e]; }
#pragma unroll
    for (int e = 0; e < 8; ++e) { qg[16 + e] = P.in[I_QN][idx * QKD + 128 + 8 * s + e]; kg[16 + e] = P.in[I_KN][idx * QKD + 128 + 8 * s + e]; }
    float* cst = (float*)(lds + wave * 256);
    const float inv_freq = powf(10000.f, -(float)(lane & 31) * (1.f / 32.f));
    const float sgn = s < 4 ? -1.f : 1.f;
    for (int m = gw; m < MTOK; m += ngw) {
        bf16* qrow = qb + (size_t)m * 1536 + h * QKD; const bf16* krow = knope + (size_t)m * 1024 + h * 128;
        const u32x4 qa = *(const u32x4*)(qrow + 16 * s), qc = *(const u32x4*)(qrow + 16 * s + 8), qr = *(const u32x4*)(qrow + 128 + 8 * s);
        const u32x4 ka = *(const u32x4*)(krow + 16 * s), kc = *(const u32x4*)(krow + 16 * s + 8), kr = *(const u32x4*)(kpe + (size_t)m * 64 + 8 * s);
        {
            const float ang = (float)pos[m] * inv_freq;
            const float n = rintf(ang * 0.15915494309189535f);
            float rr = fmaf(-n, 6.28318548202514648f, ang); rr = fmaf(-n, -1.7484555e-7f, rr);
            if (lane < 32) { cst[lane] = __cosf(rr); cst[32 + lane] = __sinf(rr); }
        }
        asm volatile("s_waitcnt lgkmcnt(0)" ::: "memory");
        float cs[8], sn[8];
        { const f32x4 c0 = *(const f32x4*)(cst + 8 * (s & 3)), c1 = *(const f32x4*)(cst + 8 * (s & 3) + 4), s0 = *(const f32x4*)(cst + 32 + 8 * (s & 3)), s1 = *(const f32x4*)(cst + 32 + 8 * (s & 3) + 4);
          cs[0] = c0.x; cs[1] = c0.y; cs[2] = c0.z; cs[3] = c0.w; cs[4] = c1.x; cs[5] = c1.y; cs[6] = c1.z; cs[7] = c1.w;
          sn[0] = s0.x; sn[1] = s0.y; sn[2] = s0.z; sn[3] = s0.w; sn[4] = s1.x; sn[5] = s1.y; sn[6] = s1.z; sn[7] = s1.w; }
#pragma unroll
        for (int which = 0; which < 2; ++which) {
            float x0[8], x1[8], xr[8];
            unpack8(which ? ka : qa, x0); unpack8(which ? kc : qc, x1); unpack8(which ? kr : qr, xr);
            float ss = 0.f;
#pragma unroll
            for (int e = 0; e < 8; ++e) ss += x0[e] * x0[e] + x1[e] * x1[e] + xr[e] * xr[e];
            ss += shfl_xor_l(ss, lane, 1); ss += shfl_xor_l(ss, lane, 2); ss += shfl_xor_l(ss, lane, 4);
            const float rn = rsqrtf(ss * (1.f / QKD) + NORM_EPS) * (which ? 1.f : ATTN_C2);
            float o0[8], o1[8], orr[8];
#pragma unroll
            for (int e = 0; e < 8; ++e) {
                const float g0 = which ? kg[e] : qg[e], g1 = which ? kg[8 + e] : qg[8 + e], g2 = which ? kg[16 + e] : qg[16 + e];
                o0[e] = x0[e] * rn * g0; o1[e] = x1[e] * rn * g1;
                const float val = xr[e] * rn * g2;
                const float par = shfl_xor_l(val, lane, 4);
                orr[e] = val * cs[e] + sgn * par * sn[e];
            }
            bf16* orow = which ? kf + (size_t)m * 1536 + h * QKD : qrow;
            *(u32x4*)(orow + 16 * s) = pack8(o0); *(u32x4*)(orow + 16 * s + 8) = pack8(o1); *(u32x4*)(orow + 128 + 8 * s) = pack8(orr);
        }
    }
}

constexpr int AT_KB = 64 * QKD * 2, AT_VB = VD * 64 * 2;
__device__ __forceinline__ void attn_phase(const Params& P, unsigned char* lds, int tid, int wave, int lane) {
    const int BIDX = bidx(), GDIMX = gdimx();
    const bf16* Q = (const bf16*)(P.ws + WS_QB); const bf16* Kf = (const bf16*)(P.ws + WS_KF); const bf16* VT = (const bf16*)(P.ws + WS_VT); bf16* O = (bf16*)(P.ws + WS_H);
    const int fr = lane & 15, g = lane >> 4;
    LAS unsigned char* ldsl = (LAS unsigned char*)lds;
    const int vcu = (GDIMX % 8 == 0) ? (BIDX % 8) * (GDIMX / 8) + BIDX / 8 : BIDX;
    for (int unit = vcu; unit < 1024; unit += GDIMX) {
        const int v = unit & 255, ui = unit >> 8, bh = v >> 2, s = v & 3;
        const int qb = (ui == 0) ? s : (ui == 1) ? 7 - s : (ui == 2) ? 8 + s : 15 - s;
        const int b = bh >> 3, h = bh & 7, q0 = qb * 256, NT = (q0 + 256) / 64;
        const size_t bT = (size_t)b * SEQ;
        bf16x8 qf[2][6];
#pragma unroll
        for (int qi = 0; qi < 2; ++qi)
#pragma unroll
            for (int ks = 0; ks < 6; ++ks) qf[qi][ks] = *(const bf16x8*)(Q + (bT + q0 + 32 * wave + 16 * qi + fr) * 1536 + h * QKD + 32 * ks + 8 * g);
        pg8::f32x4 oacc[8][2];
#pragma unroll
        for (int db = 0; db < 8; ++db) { oacc[db][0] = (pg8::f32x4){0.f, 0.f, 0.f, 0.f}; oacc[db][1] = (pg8::f32x4){0.f, 0.f, 0.f, 0.f}; }
        float mrun[2] = {-1e30f, -1e30f}, lsum[2] = {0.f, 0.f};
#define AT_KDMA(j, bufi) do { \
            _Pragma("unroll") for (int i = 0; i < 3; ++i) { const int blk = wave + 8 * i, kb_ = blk / 6, ks_ = blk - kb_ * 6; \
                __builtin_amdgcn_global_load_lds((const unsigned*)(Kf + (bT + 64 * (j) + 16 * kb_ + fr) * 1536 + h * QKD + 32 * ks_ + 8 * g), (LAS unsigned*)(ldsl + (bufi) * AT_KB + blk * 1024), 16, 0, 0); } } while (0)
#define AT_VDMA(j, bufi) do { \
            _Pragma("unroll") for (int i = 0; i < 2; ++i) { const int blk = wave + 8 * i; \
                __builtin_amdgcn_global_load_lds((const unsigned*)(VT + (size_t)(h * VD + 16 * (blk >> 1) + fr) * MTOK + bT + 64 * (j) + 32 * (blk & 1) + 8 * g), (LAS unsigned*)(ldsl + 2 * AT_KB + (bufi) * AT_VB + blk * 1024), 16, 0, 0); } } while (0)
#define AT_VFRAG(dst, vb, db) do { \
            dst[0] = *(const u32x4*)((vb) + ((((db) * 2 + 0) * 4 + g) * 16 + fr) * 16); dst[1] = *(const u32x4*)((vb) + ((((db) * 2 + 1) * 4 + g) * 16 + fr) * 16); } while (0)
#define AT_PV(vb) do { u32x4 vfr_[2][2]; AT_VFRAG(vfr_[0], vb, 0); \
            _Pragma("unroll") for (int db = 0; db < 8; ++db) { \
                if (db + 1 < 8) AT_VFRAG(vfr_[(db + 1) & 1], vb, db + 1); \
                __builtin_amdgcn_sched_barrier(0); \
                _Pragma("unroll") for (int k2 = 0; k2 < 2; ++k2) { \
                    const bf16x8 vfrag_ = __builtin_bit_cast(bf16x8, vfr_[db & 1][k2]); \
                    oacc[db][0] = __builtin_amdgcn_mfma_f32_16x16x32_bf16(vfrag_, pf[0][k2], oacc[db][0], 0, 0, 0); \
                    oacc[db][1] = __builtin_amdgcn_mfma_f32_16x16x32_bf16(vfrag_, pf[1][k2], oacc[db][1], 0, 0, 0); } \
                __builtin_amdgcn_sched_barrier(0); } } while (0)
        const bool lag = wave >= 4; bool pend = false;
        bf16x8 pf[2][2];
#pragma unroll
        for (int qi = 0; qi < 2; ++qi) { pf[qi][0] = (bf16x8){0, 0, 0, 0, 0, 0, 0, 0}; pf[qi][1] = (bf16x8){0, 0, 0, 0, 0, 0, 0, 0}; }
        AT_KDMA(0, 0);
        AT_VDMA(0, 0);
        asm volatile("s_waitcnt vmcnt(0) lgkmcnt(0)" ::: "memory");
        __syncthreads();
        int vi = 0, vprev = 2, vnext = 1;
        for (int j = 0; j < NT; ++j) {
            if (j + 1 < NT) { AT_KDMA(j + 1, (j + 1) & 1); AT_VDMA(j + 1, vnext); }
            const unsigned char* kb = lds + (j & 1) * AT_KB; const unsigned char* vb = lds + 2 * AT_KB + vi * AT_VB;
            if (pend) { const unsigned char* vbp = lds + 2 * AT_KB + vprev * AT_VB; AT_PV(vbp); pend = false; }
            if (64 * j <= q0 + 32 * wave + 31) {
                pg8::f32x4 sacc[4][2];
#pragma unroll
                for (int kb4 = 0; kb4 < 4; ++kb4) { sacc[kb4][0] = (pg8::f32x4){0.f, 0.f, 0.f, 0.f}; sacc[kb4][1] = (pg8::f32x4){0.f, 0.f, 0.f, 0.f}; }
                bf16x8 kfr[2][4];
#pragma unroll
                for (int kb4 = 0; kb4 < 4; ++kb4) kfr[0][kb4] = *(const bf16x8*)(kb + ((((kb4 * 6 + 0) * 4 + g) * 16 + fr) * 16));
#pragma unroll
                for (int ks = 0; ks < 6; ++ks) {
                    if (ks + 1 < 6) {
#pragma unroll
                        for (int kb4 = 0; kb4 < 4; ++kb4) kfr[(ks + 1) & 1][kb4] = *(const bf16x8*)(kb + ((((kb4 * 6 + ks + 1) * 4 + g) * 16 + fr) * 16));
                    }
                    __builtin_amdgcn_sched_barrier(0);
#pragma unroll
                    for (int kb4 = 0; kb4 < 4; ++kb4) {
                        sacc[kb4][0] = __builtin_amdgcn_mfma_f32_16x16x32_bf16(kfr[ks & 1][kb4], qf[0][ks], sacc[kb4][0], 0, 0, 0);
                        sacc[kb4][1] = __builtin_amdgcn_mfma_f32_16x16x32_bf16(kfr[ks & 1][kb4], qf[1][ks], sacc[kb4][1], 0, 0, 0);
                    }
                    __builtin_amdgcn_sched_barrier(0);
                }
                if (j >= NT - 4) {
#pragma unroll
                    for (int qi = 0; qi < 2; ++qi) { const int qpos = q0 + 32 * wave + 16 * qi + fr;
#pragma unroll
                        for (int kb4 = 0; kb4 < 4; ++kb4)
#pragma unroll
                            for (int r = 0; r < 4; ++r) if (64 * j + 16 * kb4 + 4 * g + r > qpos) sacc[kb4][qi][r] = -1e30f; }
                }
#pragma unroll
                for (int qi = 0; qi < 2; ++qi) {
                    float mx = -1e30f;
#pragma unroll
                    for (int kb4 = 0; kb4 < 4; ++kb4)
#pragma unroll
                        for (int r = 0; r < 4; ++r) mx = fmaxf(mx, sacc[kb4][qi][r]);
                    mx = fmaxf(mx, shfl_xor_l(mx, lane, 16)); mx = fmaxf(mx, shfl_xor_l(mx, lane, 32));
                    const float mnew = fmaxf(mrun[qi], mx);
                    const float alpha = __builtin_amdgcn_exp2f(mrun[qi] - mnew);
                    mrun[qi] = mnew;
                    float ps = 0.f;
#pragma unroll
                    for (int kb4 = 0; kb4 < 4; ++kb4)
#pragma unroll
                        for (int r = 0; r < 4; ++r) { const float p = __builtin_amdgcn_exp2f(sacc[kb4][qi][r] - mnew); sacc[kb4][qi][r] = p; ps += p; }
                    lsum[qi] = lsum[qi] * alpha + ps;
#pragma unroll
                    for (int db = 0; db < 8; ++db) { oacc[db][qi][0] *= alpha; oacc[db][qi][1] *= alpha; oacc[db][qi][2] *= alpha; oacc[db][qi][3] *= alpha; }
#pragma unroll
                    for (int k2 = 0; k2 < 2; ++k2) {
                        u32x4 w; w.x = pk2(sacc[2 * k2][qi][0], sacc[2 * k2][qi][1]); w.y = pk2(sacc[2 * k2][qi][2], sacc[2 * k2][qi][3]);
                        w.z = pk2(sacc[2 * k2 + 1][qi][0], sacc[2 * k2 + 1][qi][1]); w.w = pk2(sacc[2 * k2 + 1][qi][2], sacc[2 * k2 + 1][qi][3]);
                        pf[qi][k2] = __builtin_bit_cast(bf16x8, w);
                    }
                }
                if (lag) pend = true; else AT_PV(vb);
            }
            asm volatile("s_waitcnt vmcnt(0) lgkmcnt(0)" ::: "memory");
            __syncthreads();
            { const int t_ = vprev; vprev = vi; vi = vnext; vnext = t_; }
        }
        if (pend) { const unsigned char* vbp = lds + 2 * AT_KB + vprev * AT_VB; AT_PV(vbp); }
#pragma unroll
        for (int qi = 0; qi < 2; ++qi) {
            float l = lsum[qi]; l += shfl_xor_l(l, lane, 16); l += shfl_xor_l(l, lane, 32);
            const float inv = 1.f / l;
            bf16* orow = O + (bT + q0 + 32 * wave + 16 * qi + fr) * DM + h * VD + 4 * g;
#pragma unroll
            for (int db = 0; db < 8; ++db) { u32x2 w; w.x = pk2(oacc[db][qi][0] * inv, oacc[db][qi][1] * inv); w.y = pk2(oacc[db][qi][2] * inv, oacc[db][qi][3] * inv); *(u32x2*)(orow + 16 * db) = w; }
        }
        asm volatile("s_waitcnt lgkmcnt(0)" ::: "memory");
        __syncthreads();
#undef AT_VFRAG
#undef AT_PV
#undef AT_KDMA
#undef AT_VDMA
    }
}

#define XB_TMO      128
#define XB_XCNT(j)  (256  + 64 * (j))
#define XB_XSUB(j)  (1280 + 64 * (j))
#define XB_XGEN(j)  (2304 + 64 * (j))
#define XB_TOP      3328
#define XB_TOPGEN   3392
#define XCD_BAR_WORDS 3456
#define XB_SPIN_CAP (1u << 18)

__device__ __forceinline__ unsigned xb_ld(unsigned* p)              { return __hip_atomic_load(p, __ATOMIC_RELAXED, __HIP_MEMORY_SCOPE_AGENT); }
__device__ __forceinline__ unsigned xb_add(unsigned* p, unsigned v) { return __hip_atomic_fetch_add(p, v, __ATOMIC_RELAXED, __HIP_MEMORY_SCOPE_AGENT); }
__device__ __forceinline__ unsigned xb_xcc_id() { return (unsigned)__builtin_amdgcn_s_getreg((3 << 11) | 20) & 0xFu; }
#define XB_SPIN(cond, bar) do { unsigned _sp = 0; while (cond) { __builtin_amdgcn_s_sleep(1); \
    if ((++_sp & 255u) == 0u) { if (xb_ld(&(bar)[XB_TMO])) break; if (_sp > XB_SPIN_CAP) { atomicAdd(&(bar)[XB_TMO], 1u); break; } } } } while (0)

struct XcdBarrier {
    unsigned* bar; unsigned x;
    volatile LAS unsigned* st;
};

__device__ __forceinline__ XcdBarrier xcd_barrier_post(unsigned* bar, volatile LAS unsigned* st) {
    XcdBarrier b; b.bar = bar; b.x = xb_xcc_id(); b.st = st;
    if (threadIdx.x == 0) (void)xb_add(&bar[XB_XCNT(b.x)], 1u);
    return b;
}
__device__ __forceinline__ void xcd_barrier_complete(unsigned* bar, unsigned x, unsigned& nloc, unsigned& nx) {
    const unsigned G = gridDim.x * gridDim.y * gridDim.z;
    unsigned sum, cnt, mine, sp = 0u;
    for (;;) {
        sum = 0u; cnt = 0u; mine = 0u;
#pragma unroll
        for (unsigned j = 0; j < 16; ++j) { const unsigned c = xb_ld(&bar[XB_XCNT(j)]); sum += c; cnt += (c > 0u) ? 1u : 0u; mine = (j == x) ? c : mine; }
        if (sum == G) break;
        __builtin_amdgcn_s_sleep(1);
        if ((++sp & 255u) == 0u) { if (xb_ld(&bar[XB_TMO])) break; if (sp > XB_SPIN_CAP) { atomicAdd(&bar[XB_TMO], 1u); break; } }
    }
    nloc = mine > 0u ? mine : 1u; nx = cnt > 0u ? cnt : 1u;
}

__device__ __forceinline__ void xcd_barrier(const XcdBarrier& b) {
    asm volatile("s_waitcnt vmcnt(0)" ::: "memory");
    __syncthreads();
    if (threadIdx.x == 0) {
        unsigned* bar = b.bar;
        __builtin_amdgcn_s_waitcnt(0);
        unsigned nloc = b.st[0], nx = b.st[1];
        if (nloc == 0u) { xcd_barrier_complete(bar, b.x, nloc, nx); b.st[0] = nloc; b.st[1] = nx; }
        const unsigned old = xb_add(&bar[XB_XSUB(b.x)], 1u);
        const unsigned gen = old / nloc;
        if (old + 1u == (gen + 1u) * nloc) {
            __builtin_amdgcn_fence(__ATOMIC_RELEASE, "agent");
            asm volatile("s_waitcnt vmcnt(0)" ::: "memory");
            const unsigned og = xb_add(&bar[XB_TOP], 1u);
            const unsigned tg = og / nx;
            if (og + 1u == (tg + 1u) * nx) xb_add(&bar[XB_TOPGEN], 1u);
            else XB_SPIN(xb_ld(&bar[XB_TOPGEN]) == tg, bar);
            __builtin_amdgcn_fence(__ATOMIC_ACQUIRE, "agent");
            xb_add(&bar[XB_XGEN(b.x)], 1u);
            asm volatile("s_waitcnt vmcnt(0)" ::: "memory");
        } else {
            XB_SPIN(xb_ld(&bar[XB_XGEN(b.x)]) == gen, bar);
            __builtin_amdgcn_fence(__ATOMIC_ACQUIRE, "agent");
            asm volatile("s_waitcnt vmcnt(0)" ::: "memory");
        }
    }
    __syncthreads();
}

#define GEMM_ARGS true, true
#ifndef REP_SCAN
#define REP_SCAN 1
#endif
#ifndef REP_ATTN
#define REP_ATTN 1
#endif
#ifndef REP_PREP
#define REP_PREP 1
#endif
#ifndef REP_SMALL
#define REP_SMALL 1
#endif
#define WSP() ({ size_t o_ = 0; asm volatile("" : "+s"(o_)); P.ws + o_; })
#define SYNC() do { XcdBarrier xb_; xb_.bar = (unsigned*)(WSP() + WS_CTL); xb_.x = xb_xcc_id(); xb_.st = (volatile LAS unsigned*)(lds_raw + LDS_MISC); xcd_barrier(xb_); asm volatile("" : "+s"(layer), "+s"(ff)); } while (0)
#define SYNC_CG() do { grid.sync(); asm volatile("" : "+s"(layer), "+s"(ff)); } while (0)
#define TIDS() int tid_ = threadIdx.x; asm volatile("" : "+v"(tid_)); const int tid = tid_, lane = tid & 63, wave = __builtin_amdgcn_readfirstlane(tid >> 6); const int G = gdimx(), bidx_ = bidx(), gw = bidx_ * NWAVES + wave, ngw = G * NWAVES; (void)bidx_; (void)lane; (void)gw; (void)ngw; (void)G
__global__ void __launch_bounds__(NTHR, 2) mega_fwd(Params P) {
    extern __shared__ __attribute__((aligned(16))) unsigned char lds_raw[];
    cg::grid_group grid = cg::this_grid();
    int ff = 0;
    if (threadIdx.x < 4) ((volatile LAS unsigned*)(lds_raw + LDS_MISC))[threadIdx.x] = 0u;
    __syncthreads();
    (void)xcd_barrier_post((unsigned*)(P.ws + WS_CTL), (volatile LAS unsigned*)(lds_raw + LDS_MISC));
#pragma unroll 1
    for (int layer = 0; layer < DEPTH; ++layer) {
        {
            TIDS(); unsigned char* ws = WSP();
#ifndef NO_CONV_W
            convert_layer_weights(P, layer, (float*)(lds_raw + wave * 16384), gw, ngw, lane);
#endif
            rms_phase(layer == 0 ? P.in[I_X] : P.out, layer == 0 ? P.out : nullptr, P.in[I_GAINS] + (size_t)layer * 3 * DM, (bf16*)(ws + WS_H), gw, ngw, lane);
        }
        { int never_ = 0; asm volatile("" : "+s"(never_)); if (never_) SYNC_CG(); }
        SYNC();
#pragma unroll 1
        for (ff = 0; ff < 2; ++ff) {
            if (ff == 1) { TIDS(); unsigned char* ws = WSP(); rms_phase(P.out, nullptr, P.in[I_GAINS] + (size_t)layer * 3 * DM + 2 * DM, (bf16*)(ws + WS_H), gw, ngw, lane); SYNC(); }
            {
                unsigned char* ws = WSP();
                pg8::Gemm g{(const bf16*)(ws + WS_H), (const bf16*)(ws + (ff ? WS_WGU1 : WS_WGU0)), MTOK, 2 * DFF, DM}; pg8::StaticOrder S; S.init(MTOK, 2 * DFF, gdimx(), bidx());
                EpiSwiGLU E{(bf16*)(ws + WS_ACT), DFF};

#ifndef NO_G_GU
pg8::gemm_phase<EpiSwiGLU, pg8::StaticOrder, GEMM_ARGS>((LAS unsigned char*)lds_raw, g, S, E);
#endif

            }
            SYNC();
            {
                unsigned char* ws = WSP();
                pg8::Gemm g{(const bf16*)(ws + WS_ACT), (const bf16*)(ws + (ff ? WS_WD1 : WS_WD0)), MTOK, DM, DFF}; pg8::StaticOrder S; S.init(MTOK, DM, gdimx(), bidx());
                EpiResidual E{P.out, DM, 0.5f};

#ifndef NO_G_D
pg8::gemm_phase<EpiResidual, pg8::StaticOrder, GEMM_ARGS>((LAS unsigned char*)lds_raw, g, S, E);
#endif

            }
            if (!(layer == DEPTH - 1 && ff == 1)) SYNC();
            if (ff == 0) {
                { TIDS(); unsigned char* ws = WSP(); rms_phase(P.out, nullptr, P.in[I_GAINS] + (size_t)layer * 3 * DM + DM, (bf16*)(ws + WS_H), gw, ngw, lane); }
                SYNC();
                {
                    unsigned char* ws = WSP();
                    const bool even = !(layer & 1);
                    const int N = even ? 3328 : 768;
                    pg8::Gemm g{(const bf16*)(ws + WS_H), (const bf16*)(ws + WS_WIN), MTOK, N, DM}; pg8::StaticOrder S; S.init(MTOK, N, gdimx(), bidx());
                    EpiStore E;
                    if (even) { E.O0 = (bf16*)(ws + WS_PCONV); E.ldc0 = PCONV_LD; E.ntile0 = 6; E.O1 = (bf16*)(ws + WS_PRW); E.ldc1 = PRW_LD; }
                    else { E.O0 = (bf16*)(ws + WS_PODD); E.ldc0 = PODD_LD; E.ntile0 = 1 << 20; E.O1 = (bf16*)(ws + WS_PODD); E.ldc1 = PODD_LD; }

#ifndef NO_G_WIN
pg8::gemm_phase<EpiStore, pg8::StaticOrder, GEMM_ARGS>((LAS unsigned char*)lds_raw, g, S, E);
#endif

                }
                SYNC();
                if (!(layer & 1)) {
#ifndef NO_CONV
                    { unsigned char* ws = WSP(); TIDS(); conv_phase((const bf16*)(ws + WS_PCONV), P.in[I_ECONV] + (size_t)(layer >> 1) * 3 * 512, (bf16*)(ws + WS_H), bidx_ * NTHR + tid, G * NTHR); }
#endif
                    SYNC();
#ifndef NO_PREP
                    for (int rep_ = 0; rep_ < REP_PREP; ++rep_) { TIDS(); prep_phase<true>(P, layer >> 1, lds_raw, tid, wave, lane); }
#if REP_PREP == 2
                    { TIDS(); prep_phase<false>(P, layer >> 1, lds_raw, tid, wave, lane); }
#endif
#if REP_PREP == 3
                    { TIDS(); prep_phase<true>(P, layer >> 1, lds_raw, tid, wave, lane); }
#endif
#endif
                    SYNC();
#ifndef NO_SCAN
                    for (int rep_ = 0; rep_ < REP_SCAN; ++rep_) { TIDS(); scan_phase(P, (float*)lds_raw, tid, wave, lane); }
#endif
                    SYNC();
#ifndef NO_POST
                    for (int rep_ = 0; rep_ < REP_SMALL; ++rep_) { TIDS(); post_phase(P, layer >> 1, lds_raw, gw, ngw, wave, lane); }
#endif
                    SYNC();
                } else {
#ifndef NO_MLAN
                    for (int rep_ = 0; rep_ < REP_SMALL; ++rep_) { TIDS(); mla_norm_phase(P, layer >> 1, gw, ngw, lane); }
#endif
                    SYNC();
#ifndef NO_G_3
                    {   unsigned char* ws = WSP();
                        pg8::Gemm g{(const bf16*)(ws + WS_CQN), (const bf16*)(ws + WS_WQ), MTOK, 1536, QRANK}; pg8::StaticOrder S; S.init(MTOK, 1536, gdimx(), bidx());
                        EpiStore E{(bf16*)(ws + WS_QB), 1536, 1 << 20, (bf16*)(ws + WS_QB), 1536};
                        pg8::gemm_phase<EpiStore, pg8::StaticOrder, GEMM_ARGS>((LAS unsigned char*)lds_raw, g, S, E); }
                    asm volatile("" : "+s"(layer), "+s"(ff));
                    {   unsigned char* ws = WSP();
                        pg8::Gemm g{(const bf16*)(ws + WS_CKVN), (const bf16*)(ws + WS_WK), MTOK, 1024, KVRANK}; pg8::StaticOrder S; S.init(MTOK, 1024, gdimx(), bidx());
                        EpiStore E{(bf16*)(ws + WS_KNOPE), 1024, 1 << 20, (bf16*)(ws + WS_KNOPE), 1024};
                        pg8::gemm_phase<EpiStore, pg8::StaticOrder, GEMM_ARGS>((LAS unsigned char*)lds_raw, g, S, E); }
                    asm volatile("" : "+s"(layer), "+s"(ff));
                    {   unsigned char* ws = WSP();
                        pg8::Gemm g{(const bf16*)(ws + WS_WV), (const bf16*)(ws + WS_CKVN), 1024, MTOK, KVRANK}; pg8::StaticOrder S; S.init(1024, MTOK, gdimx(), bidx());
                        EpiStoreV E; E.O0 = (bf16*)(ws + WS_VT); E.ldc0 = MTOK; E.ntile0 = 1 << 20; E.O1 = E.O0; E.ldc1 = MTOK;
                        pg8::gemm_phase<EpiStoreV, pg8::StaticOrder, false, true>((LAS unsigned char*)lds_raw, g, S, E); }
#endif
                    SYNC();
#ifndef NO_QKP
                    { TIDS(); qk_prep_phase(P, layer >> 1, lds_raw, gw, ngw, wave, lane); }
#endif
                    SYNC();
#ifndef NO_ATTN
                    for (int rep_ = 0; rep_ < REP_ATTN; ++rep_) { TIDS(); attn_phase(P, lds_raw, tid, wave, lane); }
#endif
                    SYNC();
                }
                {
                    unsigned char* ws = WSP();
                    pg8::Gemm g{(const bf16*)(ws + WS_H), (const bf16*)(ws + WS_WOUT), MTOK, DM, DM}; pg8::StaticOrder S; S.init(MTOK, DM, gdimx(), bidx());
                    EpiResidual E{P.out, DM, 1.0f};

#ifndef NO_G_OUT
pg8::gemm_phase<EpiResidual, pg8::StaticOrder, GEMM_ARGS>((LAS unsigned char*)lds_raw, g, S, E);
#endif

                }
                SYNC();
            }
        }
    }
}

extern "C" void kernel_launch(void* const* d_in, const int* in_sizes, int n_in, void* d_out, int out_size, void* d_ws, size_t ws_size, hipStream_t stream) {
    static int grid = 0;
    if (grid == 0) {
        if (n_in != 28 || out_size != MTOK * DM || ws_size < WS_END) { fprintf(stderr, "kernel_launch: unexpected problem (n_in %d, out %d, ws %zu < %zu)\n", n_in, out_size, ws_size, (size_t)WS_END); grid = -1; return; }
        int dev = 0, cus = 0, per_cu = 0;
        hipGetDevice(&dev); hipDeviceGetAttribute(&cus, hipDeviceAttributeMultiprocessorCount, dev);
        hipFuncSetAttribute((const void*)mega_fwd, hipFuncAttributeMaxDynamicSharedMemorySize, LDS_BYTES);
        hipOccupancyMaxActiveBlocksPerMultiprocessor(&per_cu, (const void*)mega_fwd, NTHR, LDS_BYTES);
        if (per_cu < 1) per_cu = 1;
        grid = cus * per_cu;
        (void)hipGetLastError();
    }
    if (grid < 0) return;
    if (hipMemsetAsync((char*)d_ws + WS_CTL, 0, CTL_BYTES, stream) != hipSuccess) { fprintf(stderr, "memset failed\n"); return; }
    Params p{};
    for (int i = 0; i < 28; ++i) p.in[i] = (const float*)d_in[i];
    p.out = (float*)d_out; p.ws = (unsigned char*)d_ws;
    void* args[] = {&p};
    hipError_t e = hipLaunchCooperativeKernel((const void*)mega_fwd, dim3(grid), dim3(NTHR), args, LDS_BYTES, stream);
    if (e != hipSuccess) fprintf(stderr, "cooperative launch failed: %s (grid %d)\n", hipGetErrorString(e), grid);
}
```
